# Optimizing an MI355X kernel written in HIP

```python
import math
import jax, jax.numpy as jnp
from jax import lax
import numpy as np

D_MODEL = 1024
BATCH = 8
SEQ = 4096
DEPTH = 1

MLA_HEADS = 8
MLA_NOPE = 128
MLA_ROPE = 64
MLA_V = 128
Q_LORA = 384
KV_LORA = 256
ROPE_THETA = 10000.0
SWA_HEADS = 8
SWA_KV_HEADS = 2
SWA_HEAD_DIM = 128
WINDOW = 128
BLOCK = 128
N_BUCKETS = 32
MAX_DISTANCE = 128
D_FF = 4 * D_MODEL
N_BRANCHES = 2
N_MOD = 6
EPS = 1e-6
NEG_INF = -1e30

SPLITS = (Q_LORA, KV_LORA, MLA_ROPE,
          SWA_HEADS * SWA_HEAD_DIM, SWA_KV_HEADS * SWA_HEAD_DIM, SWA_KV_HEADS * SWA_HEAD_DIM,
          N_BRANCHES * D_MODEL)
D_IN = sum(SPLITS)

kernel_name = "hybrid_mla_swa_gated_encoder_block"


def rmsnorm(x, g):
    xf = x.astype(jnp.float32)
    y = xf * lax.rsqrt(jnp.mean(xf * xf, axis=-1, keepdims=True) + EPS) * g.astype(jnp.float32)
    return y.astype(x.dtype)


def rope_angles(pos, dim):
    inv = ROPE_THETA ** (-jnp.arange(0, dim, 2, dtype=jnp.float32) / dim)
    ang = pos.astype(jnp.float32)[..., None] * inv
    return jnp.cos(ang), jnp.sin(ang)


def apply_rope(x, cos, sin):
    half = x.shape[-1] // 2
    x1 = x[..., :half].astype(jnp.float32)
    x2 = x[..., half:].astype(jnp.float32)
    out = jnp.concatenate([x1 * cos - x2 * sin, x2 * cos + x1 * sin], axis=-1)
    return out.astype(x.dtype)


def t5_bucket(rel):
    half = N_BUCKETS // 2
    max_exact = half // 2
    ret = jnp.where(rel > 0, half, 0)
    n = jnp.abs(rel)
    nf = jnp.maximum(n, 1).astype(jnp.float32)
    large = max_exact + (jnp.log(nf / max_exact) / math.log(MAX_DISTANCE / max_exact)
                         * (half - max_exact)).astype(jnp.int32)
    large = jnp.minimum(large, half - 1)
    return ret + jnp.where(n < max_exact, n, large)


def mla_branch(cq, ckv, kr, pos, q_norm, w_uq, kv_norm, w_ukv):
    B, S, _ = cq.shape
    nb = S // BLOCK
    q = (rmsnorm(cq, q_norm) @ w_uq).reshape(B, S, MLA_HEADS, MLA_NOPE + MLA_ROPE)
    q_nope, q_rope = q[..., :MLA_NOPE], q[..., MLA_NOPE:]
    kv = (rmsnorm(ckv, kv_norm) @ w_ukv).reshape(B, S, MLA_HEADS, MLA_NOPE + MLA_V)
    k_nope, v = kv[..., :MLA_NOPE], kv[..., MLA_NOPE:]
    cos, sin = rope_angles(pos, MLA_ROPE)
    q_rope = apply_rope(q_rope, cos[:, :, None], sin[:, :, None])
    k_rope = apply_rope(kr, cos, sin)
    scale = (MLA_NOPE + MLA_ROPE) ** -0.5
    qn_b = q_nope.reshape(B, nb, BLOCK, MLA_HEADS, MLA_NOPE).transpose(1, 0, 2, 3, 4)
    qr_b = q_rope.reshape(B, nb, BLOCK, MLA_HEADS, MLA_ROPE).transpose(1, 0, 2, 3, 4)

    def attend(args):
        qn, qr = args
        s = (jnp.einsum('bqhd,bkhd->bhqk', qn, k_nope)
             + jnp.einsum('bqhr,bkr->bhqk', qr, k_rope))
        p = jax.nn.softmax(s.astype(jnp.float32) * scale, axis=-1).astype(v.dtype)
        return jnp.einsum('bhqk,bkhd->bqhd', p, v)

    o = lax.map(attend, (qn_b, qr_b))
    return o.transpose(1, 0, 2, 3, 4).reshape(B, S, MLA_HEADS * MLA_V)


def swa_branch(q, k, v, pos, rel_bias, sink):
    B, S, _ = q.shape
    nb = S // BLOCK
    G = SWA_HEADS // SWA_KV_HEADS
    span = BLOCK + 2 * WINDOW
    q = q.reshape(B, S, SWA_KV_HEADS, G, SWA_HEAD_DIM) * (SWA_HEAD_DIM ** -0.5)
    k = k.reshape(B, S, SWA_KV_HEADS, SWA_HEAD_DIM)
    v = v.reshape(B, S, SWA_KV_HEADS, SWA_HEAD_DIM)
    pad = ((0, 0), (WINDOW, WINDOW), (0, 0), (0, 0))
    kp = jnp.pad(k, pad)
    vp = jnp.pad(v, pad)
    posp = jnp.pad(pos, ((0, 0), (WINDOW, WINDOW)))
    validp = jnp.pad(jnp.ones((S,), dtype=bool), (WINDOW, WINDOW))
    q_b = q.reshape(B, nb, BLOCK, SWA_KV_HEADS, G, SWA_HEAD_DIM).transpose(1, 0, 2, 3, 4, 5)
    pq_b = pos.reshape(B, nb, BLOCK).transpose(1, 0, 2)
    starts = jnp.arange(nb, dtype=jnp.int32) * BLOCK
    bias_tab = rel_bias.astype(jnp.float32)
    sink_f = sink.astype(jnp.float32).reshape(1, SWA_KV_HEADS, G, 1, 1)

    def attend(args):
        qb, pqb, start = args
        kb = lax.dynamic_slice_in_dim(kp, start, span, axis=1)
        vb = lax.dynamic_slice_in_dim(vp, start, span, axis=1)
        pk = lax.dynamic_slice_in_dim(posp, start, span, axis=1)
        ok = lax.dynamic_slice_in_dim(validp, start, span, axis=0)
        rel = pk[:, None, :] - pqb[:, :, None]
        mask = ok[None, None, :] & (jnp.abs(rel) <= WINDOW)
        bias = bias_tab[t5_bucket(rel)]
        bias = bias.transpose(0, 3, 1, 2).reshape(B, SWA_KV_HEADS, G, BLOCK, span)
        s = jnp.einsum('bqngd,bknd->bngqk', qb, kb).astype(jnp.float32) + bias
        s = jnp.where(mask[:, None, None], s, NEG_INF)
        sk = jnp.broadcast_to(sink_f, (B, SWA_KV_HEADS, G, BLOCK, 1))
        p = jax.nn.softmax(jnp.concatenate([s, sk], axis=-1), axis=-1)[..., :-1]
        return jnp.einsum('bngqk,bknd->bqngd', p.astype(vb.dtype), vb)

    o = lax.map(attend, (q_b, pq_b, starts))
    return o.transpose(1, 0, 2, 3, 4, 5).reshape(B, S, SWA_HEADS * SWA_HEAD_DIM)


def setup_inputs(seed: int = 0) -> dict:
    key = jax.random.key(seed)
    ks = jax.random.split(key, 24)
    D = D_MODEL
    f32 = jnp.float32

    def w(k, shape, fan_in, gain=1.0):
        return jax.random.normal(k, shape, f32) * (gain * fan_in ** -0.5)

    def gain(k, shape):
        return 1.0 + 0.01 * jax.random.normal(k, shape, f32)

    x = jax.random.normal(ks[0], (BATCH, SEQ, D), f32)
    c = jax.random.normal(ks[1], (BATCH, D), f32)
    offset = jax.random.randint(ks[2], (BATCH, 1), 0, 1024, dtype=jnp.int32)
    positions = offset + jnp.arange(SEQ, dtype=jnp.int32)[None, :]
    return {
        "x": x,
        "c": c,
        "positions": positions,
        "w_ada": w(ks[3], (DEPTH, D, N_MOD * D), D, 0.1),
        "b_ada": 0.01 * jax.random.normal(ks[4], (DEPTH, N_MOD * D), f32),
        "norm_mix": gain(ks[5], (DEPTH, D)),
        "w_in": w(ks[6], (DEPTH, D, D_IN), D),
        "q_norm": gain(ks[7], (DEPTH, Q_LORA)),
        "w_uq": w(ks[8], (DEPTH, Q_LORA, MLA_HEADS * (MLA_NOPE + MLA_ROPE)), Q_LORA),
        "kv_norm": gain(ks[9], (DEPTH, KV_LORA)),
        "w_ukv": w(ks[10], (DEPTH, KV_LORA, MLA_HEADS * (MLA_NOPE + MLA_V)), KV_LORA),
        "rel_bias": 0.5 * jax.random.normal(ks[11], (N_BUCKETS, SWA_HEADS), f32),
        "sink": 0.5 * jax.random.normal(ks[12], (DEPTH, SWA_HEADS), f32),
        "w_o_mla": w(ks[13], (DEPTH, MLA_HEADS * MLA_V, D), MLA_HEADS * MLA_V),
        "w_o_swa": w(ks[14], (DEPTH, SWA_HEADS * SWA_HEAD_DIM, D), SWA_HEADS * SWA_HEAD_DIM),
        "w_out": w(ks[15], (DEPTH, D, D), D),
        "norm_mlp": gain(ks[16], (DEPTH, D)),
        "w_ff1": w(ks[17], (DEPTH, D, D_FF), D),
        "w_ff2": w(ks[18], (DEPTH, D_FF, D), D_FF),
        "norm_final": gain(ks[19], (D,)),
    }


def reference(x, c, positions, w_ada, b_ada, norm_mix, w_in, q_norm, w_uq, kv_norm, w_ukv,
              rel_bias, sink, w_o_mla, w_o_swa, w_out, norm_mlp, w_ff1, w_ff2, norm_final):
    B, S, D = x.shape
    split_idx = [int(i) for i in np.cumsum(SPLITS)[:-1]]
    c_act = jax.nn.silu(c)
    for l in range(DEPTH):
        mod = c_act @ w_ada[l] + b_ada[l]
        sh1, sc1, g1, sh2, sc2, g2 = jnp.split(mod, N_MOD, axis=-1)

        h = rmsnorm(x, norm_mix[l]) * (1.0 + sc1[:, None, :]) + sh1[:, None, :]
        proj = h @ w_in[l]
        cq, ckv, kr, qs, ks_, vs, gates = jnp.split(proj, split_idx, axis=-1)
        y_a = mla_branch(cq, ckv, kr, positions, q_norm[l], w_uq[l], kv_norm[l], w_ukv[l]) @ w_o_mla[l]
        y_b = swa_branch(qs, ks_, vs, positions, rel_bias, sink[l]) @ w_o_swa[l]
        gates = jax.nn.sigmoid(gates.astype(jnp.float32)).astype(x.dtype).reshape(B, S, N_BRANCHES, D)
        merged = gates[:, :, 0] * y_a + gates[:, :, 1] * y_b
        x = x + g1[:, None, :] * (merged @ w_out[l])

        h = rmsnorm(x, norm_mlp[l]) * (1.0 + sc2[:, None, :]) + sh2[:, None, :]
        ff = jnp.square(jax.nn.relu(h @ w_ff1[l])) @ w_ff2[l]
        x = x + g2[:, None, :] * ff
    return rmsnorm(x, norm_final)
```

```cpp
#include <hip/hip_runtime.h>
#include <hip/hip_bf16.h>
#include <cstdio>
#include <cstdint>

#ifndef DBG_MIX_SCALE
#define DBG_MIX_SCALE 1.0f
#endif
#ifndef MK_N_LAUNCHES
#define MK_N_LAUNCHES 1
#endif

constexpr int BATCH = 8, SEQ = 4096, DM = 1024, M = BATCH * SEQ;
constexpr int QL = 384, KVL = 256, LATP = 640;
constexpr int MH = 8, NOPE = 128, ROPE = 64, QKD = NOPE + ROPE, VD = 128;
constexpr int SH = 8, SKVH = 2, SHD = 128;
constexpr int DFF = 4096, DIN = 4288, DINP = 4352, NMOD = 6 * DM;
constexpr float EPS = 1e-6f, LOG2E = 1.4426950408889634f;
constexpr float C2_MLA = 0.07216878364870323f * LOG2E;
constexpr float C2_SWA = 0.08838834764831845f * LOG2E;

namespace pg8 {
#define PG8_LAS __attribute__((address_space(3)))
typedef unsigned short bf16_t;
typedef short bf16x8 __attribute__((ext_vector_type(8)));
typedef float f32x4 __attribute__((ext_vector_type(4)));
typedef float f32x2 __attribute__((ext_vector_type(2)));
typedef unsigned u32x4 __attribute__((ext_vector_type(4)));
constexpr int BM = 256, BK = 64, HALF = 128, HTB = HALF * BK * 2, STAGE_BYTES = 8 * HTB, NXCD = 8, WGM = 8;

__host__ __device__ __forceinline__ int lds_byte(int r, int c) { const int st = (r >> 4) * 2 + (c >> 5), rr = r & 15, cc = c & 31, ob = rr * 64 + cc * 2; return st * 1024 + (ob ^ (((ob >> 9) & 1) << 5)); }
__host__ __device__ __forceinline__ void stage_rc(int b, int& R, int& C) { const int st = b / 1024, sb = b % 1024, swz = sb ^ (((sb >> 9) & 1) << 5); R = (st >> 1) * 16 + swz / 64; C = (st & 1) * 32 + (swz % 64) / 2; }
__host__ __device__ __forceinline__ int perm32(int rho) { const int n = rho >> 4, i = rho & 15; return 8 * (i >> 2) + 4 * n + (i & 3); }

struct Unit { int pm, pn; };
struct Gemm { const bf16_t* A; const bf16_t* Bt; int lda, K; };

struct StaticOrder {
    int nM, nN, nwg, G, c;
    __host__ __device__ void init(int M_, int N_, int G_, int c_) { nM = M_ / BM; nN = N_ / BM; nwg = nM * nN; G = G_; c = c_; }
    __host__ __device__ bool next(int i, Unit& u) const {
        const long L = (long)i * G + c; if (L >= nwg) return false;
        int wgid = (int)L; { const int q = nwg / NXCD, r = nwg % NXCD, xcd = wgid % NXCD, off = wgid / NXCD; wgid = (xcd < r ? xcd * (q + 1) : r * (q + 1) + (xcd - r) * q) + off; }
        const int nig = WGM * nN, gid = wgid / nig, fm = gid * WGM, gsz = (nM - fm) < WGM ? (nM - fm) : WGM;
        u.pm = fm + ((wgid % nig) % gsz); u.pn = (wgid % nig) / gsz; return true;
    }
};
struct PairOrder {
    StaticOrder so;
    __host__ __device__ bool next(int i, Unit& u) const { Unit t; if (!so.next(i >> 1, t)) return false; const int s = i & 1; u.pm = t.pm + s * so.nM; u.pn = t.pn + s * so.nN; return true; }
};

__device__ __forceinline__ unsigned cvt_pk_bf16(float lo, float hi) { unsigned r; asm volatile("v_cvt_pk_bf16_f32 %0, %1, %2" : "=v"(r) : "v"(lo), "v"(hi)); return r; }
__device__ __forceinline__ u32x4 pack8(const f32x4 a, const f32x4 b) { u32x4 w; w.x = cvt_pk_bf16(a[0], a[1]); w.y = cvt_pk_bf16(a[2], a[3]); w.z = cvt_pk_bf16(b[0], b[1]); w.w = cvt_pk_bf16(b[2], b[3]); return w; }
__device__ __forceinline__ void unpack8(const u32x4 w, f32x4& a, f32x4& b) {
    a[0] = __uint_as_float(w.x << 16); a[1] = __uint_as_float(w.x & 0xffff0000u); a[2] = __uint_as_float(w.y << 16); a[3] = __uint_as_float(w.y & 0xffff0000u);
    b[0] = __uint_as_float(w.z << 16); b[1] = __uint_as_float(w.z & 0xffff0000u); b[2] = __uint_as_float(w.w << 16); b[3] = __uint_as_float(w.w & 0xffff0000u); }

typedef f32x4 Acc[2][2][4][2];
typedef unsigned u32x2 __attribute__((ext_vector_type(2)));
__device__ __forceinline__ unsigned pack4_u8(const f32x4 g) {
    const unsigned a = (unsigned)__builtin_rintf(g[0] * 255.f), b = (unsigned)__builtin_rintf(g[1] * 255.f), c = (unsigned)__builtin_rintf(g[2] * 255.f), d = (unsigned)__builtin_rintf(g[3] * 255.f);
    return a | (b << 8) | (c << 16) | (d << 24); }
__device__ __forceinline__ f32x4 unpack4_u8(unsigned w) {
    f32x4 r; r[0] = (float)(w & 255u); r[1] = (float)((w >> 8) & 255u); r[2] = (float)((w >> 16) & 255u); r[3] = (float)(w >> 24); return r * (1.f / 255.f); }

struct EpiProj {
    bf16_t *LAT, *KR, *QS, *KS, *VS; unsigned char* GT; float *ssq_q, *ssq_kv; const float* cs;
    __device__ __forceinline__ void operator()(const Acc& acc, const Unit& u, int wr, int wc, int fr, int fq) const {
        const int pn = u.pn, row0 = u.pm * BM + wr * 64 + fr, cl = wc * 32 + 8 * fq;
        if (pn <= 2) {
#pragma unroll
            for (int bj = 0; bj < 2; ++bj) {
                const int gc = pn * 256 + bj * 128;
                if (gc < LATP) {
                    float* ssq = gc < QL ? ssq_q : ssq_kv;
#pragma unroll
                    for (int ai = 0; ai < 2; ++ai)
#pragma unroll
                        for (int m = 0; m < 4; ++m) { const int row = row0 + ai * HALF + m * 16; const f32x4 v0 = acc[ai][bj][m][0], v1 = acc[ai][bj][m][1];
                            float s = (v0[0] * v0[0] + v0[1] * v0[1]) + (v0[2] * v0[2] + v0[3] * v0[3]) + (v1[0] * v1[0] + v1[1] * v1[1]) + (v1[2] * v1[2] + v1[3] * v1[3]);
                            s += __shfl_xor(s, 16); s += __shfl_xor(s, 32);
                            if (fq == 0) (void)__hip_atomic_fetch_add(ssq + row, s, __ATOMIC_RELAXED, __HIP_MEMORY_SCOPE_AGENT);
                            *(u32x4*)(LAT + (size_t)row * LATP + gc + cl) = pack8(v0, v1); }
                } else if (wc < 2) {
#pragma unroll
                    for (int ai = 0; ai < 2; ++ai)
#pragma unroll
                        for (int m = 0; m < 4; ++m) { const int row = row0 + ai * HALF + m * 16; const f32x4 v0 = acc[ai][bj][m][0], v1 = acc[ai][bj][m][1];
                            const f32x4 c0 = *(const f32x4*)(cs + (size_t)row * 64 + cl), c1 = *(const f32x4*)(cs + (size_t)row * 64 + cl + 4);
                            f32x4 o0, o1;
                            o0[0] = v0[0] * c0[0] - v0[1] * c0[1]; o0[1] = v0[1] * c0[0] + v0[0] * c0[1]; o0[2] = v0[2] * c0[2] - v0[3] * c0[3]; o0[3] = v0[3] * c0[2] + v0[2] * c0[3];
                            o1[0] = v1[0] * c1[0] - v1[1] * c1[1]; o1[1] = v1[1] * c1[0] + v1[0] * c1[1]; o1[2] = v1[2] * c1[2] - v1[3] * c1[3]; o1[3] = v1[3] * c1[2] + v1[2] * c1[3];
                            *(u32x4*)(KR + (size_t)row * ROPE + cl) = pack8(o0, o1); }
                }
            }
        } else if (pn <= 8) {
            bf16_t* base; int ldc, colt; float sc = 1.f;
            if (pn <= 6) { base = QS; ldc = DM; colt = (pn - 3) * 256; sc = C2_SWA; } else if (pn == 7) { base = KS; ldc = 256; colt = 0; } else { base = VS; ldc = 256; colt = 0; }
#pragma unroll
            for (int ai = 0; ai < 2; ++ai)
#pragma unroll
                for (int m = 0; m < 4; ++m) { bf16_t* rowp = base + (size_t)(row0 + ai * HALF + m * 16) * ldc + colt + cl;
#pragma unroll
                    for (int bj = 0; bj < 2; ++bj) *(u32x4*)(rowp + bj * HALF) = pack8(acc[ai][bj][m][0] * sc, acc[ai][bj][m][1] * sc); }
        } else {
            const int colt = (pn - 9) * 256;
#pragma unroll
            for (int ai = 0; ai < 2; ++ai)
#pragma unroll
                for (int m = 0; m < 4; ++m) { unsigned char* rowp = GT + (size_t)(row0 + ai * HALF + m * 16) * 2048 + colt + cl;
#pragma unroll
                    for (int bj = 0; bj < 2; ++bj) { f32x4 v[2];
#pragma unroll
                        for (int n = 0; n < 2; ++n)
#pragma unroll
                            for (int j = 0; j < 4; ++j) v[n][j] = __builtin_amdgcn_rcpf(1.f + __builtin_amdgcn_exp2f(-LOG2E * acc[ai][bj][m][n][j]));
                        *(u32x2*)(rowp + bj * HALF) = (u32x2){pack4_u8(v[0]), pack4_u8(v[1])}; } }
        }
    }
};
struct EpiQ {
    bf16_t* Qm; const float* ssq_q; const float* cs;
    __device__ __forceinline__ void operator()(const Acc& acc, const Unit& u, int wr, int wc, int fr, int fq) const {
        const int row0 = u.pm * BM + wr * 64 + fr;
#pragma unroll
        for (int bj = 0; bj < 2; ++bj) {
            const int gc = u.pn * 256 + bj * 128 + wc * 32, j0 = gc % QKD; const bool rope = j0 >= NOPE; const int p0 = (j0 - NOPE) + 8 * fq;
#pragma unroll
            for (int ai = 0; ai < 2; ++ai)
#pragma unroll
                for (int m = 0; m < 4; ++m) { const int row = row0 + ai * HALF + m * 16;
                    const float rs = __builtin_amdgcn_rsqf(ssq_q[row] * (1.f / QL) + EPS) * C2_MLA;
                    f32x4 v0 = acc[ai][bj][m][0] * rs, v1 = acc[ai][bj][m][1] * rs;
                    if (rope) { const f32x4 c0 = *(const f32x4*)(cs + (size_t)row * 64 + p0), c1 = *(const f32x4*)(cs + (size_t)row * 64 + p0 + 4); f32x4 o0, o1;
                        o0[0] = v0[0] * c0[0] - v0[1] * c0[1]; o0[1] = v0[1] * c0[0] + v0[0] * c0[1]; o0[2] = v0[2] * c0[2] - v0[3] * c0[3]; o0[3] = v0[3] * c0[2] + v0[2] * c0[3];
                        o1[0] = v1[0] * c1[0] - v1[1] * c1[1]; o1[1] = v1[1] * c1[0] + v1[0] * c1[1]; o1[2] = v1[2] * c1[2] - v1[3] * c1[3]; o1[3] = v1[3] * c1[2] + v1[2] * c1[3];
                        v0 = o0; v1 = o1; }
                    *(u32x4*)(Qm + (size_t)row * (MH * QKD) + gc + 8 * fq) = pack8(v0, v1);
                    asm volatile("" ::: "memory"); }
        }
    }
};
struct EpiKV {
    bf16_t* KN; bf16_t* VM; const float* ssq_kv;
    __device__ __forceinline__ void operator()(const Acc& acc, const Unit& u, int wr, int wc, int fr, int fq) const {
        const int row0 = u.pm * BM + wr * 64 + fr, col0 = u.pn * HALF + wc * 32 + 8 * fq;
#pragma unroll
        for (int ai = 0; ai < 2; ++ai)
#pragma unroll
            for (int m = 0; m < 4; ++m) { const int row = row0 + ai * HALF + m * 16; const float rs = __builtin_amdgcn_rsqf(ssq_kv[row] * (1.f / KVL) + EPS);
#pragma unroll
                for (int bj = 0; bj < 2; ++bj) *(u32x4*)((bj ? VM : KN) + (size_t)row * DM + col0) = pack8(acc[ai][bj][m][0] * rs, acc[ai][bj][m][1] * rs); }
    }
};
struct EpiMerge {
    const unsigned char* GT; bf16_t* T; bf16_t* MG; int s;
    __device__ __forceinline__ void operator()(const Acc& acc, const Unit& u, int wr, int wc, int fr, int fq) const {
        const int pm = u.pm, pn = u.pn;
        const int row0 = pm * BM + wr * 64 + fr, col0 = pn * BM + wc * 32 + 8 * fq;
#pragma unroll
        for (int ai = 0; ai < 2; ++ai)
#pragma unroll
            for (int m = 0; m < 4; ++m) { const int row = row0 + ai * HALF + m * 16;
#pragma unroll
                for (int bj = 0; bj < 2; ++bj) { const int col = col0 + bj * HALF; const u32x2 gw = *(const u32x2*)(GT + (size_t)row * 2048 + s * DM + col); const f32x4 g0 = unpack4_u8(gw.x), g1 = unpack4_u8(gw.y);
                    f32x4 v0 = acc[ai][bj][m][0] * g0, v1 = acc[ai][bj][m][1] * g1;
                    if (s == 0) *(u32x4*)(T + (size_t)row * DM + col) = pack8(v0, v1);
                    else { f32x4 t0, t1; unpack8(*(const u32x4*)(T + (size_t)row * DM + col), t0, t1); *(u32x4*)(MG + (size_t)row * DM + col) = pack8((v0 + t0) * DBG_MIX_SCALE, (v1 + t1) * DBG_MIX_SCALE); } } }
    }
};
struct EpiResid {
    const float* base; float* out; const float* gmod;
    __device__ __forceinline__ void operator()(const Acc& acc, const Unit& u, int wr, int wc, int fr, int fq) const {
        const int row0 = u.pm * BM + wr * 64 + fr, col0 = u.pn * BM + wc * 32 + 8 * fq; const float* gb = gmod + (size_t)((u.pm * BM) / SEQ) * NMOD;
        f32x4 gv[2][2];
#pragma unroll
        for (int bj = 0; bj < 2; ++bj)
#pragma unroll
            for (int n = 0; n < 2; ++n) gv[bj][n] = *(const f32x4*)(gb + col0 + bj * HALF + 4 * n);
#pragma unroll
        for (int ai = 0; ai < 2; ++ai)
#pragma unroll
            for (int m = 0; m < 4; ++m) { const size_t off = (size_t)(row0 + ai * HALF + m * 16) * DM + col0;
#pragma unroll
                for (int bj = 0; bj < 2; ++bj)
#pragma unroll
                    for (int n = 0; n < 2; ++n) { const f32x4 b = *(const f32x4*)(base + off + bj * HALF + 4 * n); *(f32x4*)(out + off + bj * HALF + 4 * n) = b + gv[bj][n] * acc[ai][bj][m][n]; }
                if (m & 1) asm volatile("" ::: "memory"); }
    }
};
struct EpiRelu2 {
    bf16_t* U;
    __device__ __forceinline__ void operator()(const Acc& acc, const Unit& u, int wr, int wc, int fr, int fq) const {
        const int row0 = u.pm * BM + wr * 64 + fr, col0 = u.pn * BM + wc * 32 + 8 * fq;
#pragma unroll
        for (int ai = 0; ai < 2; ++ai)
#pragma unroll
            for (int m = 0; m < 4; ++m) { bf16_t* rowp = U + (size_t)(row0 + ai * HALF + m * 16) * DFF + col0;
#pragma unroll
                for (int bj = 0; bj < 2; ++bj) { f32x4 v[2];
#pragma unroll
                    for (int n = 0; n < 2; ++n)
#pragma unroll
                        for (int j = 0; j < 4; ++j) { const float r = fmaxf(acc[ai][bj][m][n][j], 0.f); v[n][j] = r * r; }
                    *(u32x4*)(rowp + bj * HALF) = pack8(v[0], v[1]); } }
    }
};

template <class Epi, class Sched, bool ALIGN_EPI>
__device__ __forceinline__ void gemm_phase(PG8_LAS unsigned char* lds, const Gemm g, const Sched& S, const Epi& E) {
    int tid_ = threadIdx.x; asm volatile("" : "+v"(tid_));
    const int tid = tid_, wid = __builtin_amdgcn_readfirstlane(tid >> 6), lane = tid & 63, wr = wid >> 2, wc = wid & 3, fr = lane & 15, fq = lane >> 4;
    const int K = g.K, nt = K / BK;
    unsigned voffA[2], voffB[2];
#pragma unroll
    for (int i = 0; i < 2; ++i) { int R, C; stage_rc(tid * 16 + i * 8192, R, C); const int Rb = (R & ~31) + perm32(R & 31);
        voffA[i] = (unsigned)(R * g.lda + C) * 2u; voffB[i] = (unsigned)(Rb * K + C) * 2u; }
    const size_t kstep = (size_t)(BK * 2);
    const size_t hA = (size_t)HALF * g.lda * 2, hB = (size_t)HALF * K * 2, tA = 2 * hA, tB = 2 * hB;
    const unsigned ldsw = (unsigned)wid * 1024u;
    const int aoff = lds_byte(wr * 64 + fr, fq * 8), boff = lds_byte(wc * 32 + fr, fq * 8);
#define PG8_SA(b, h) (((b) * 2 + (h)) * HTB)
#define PG8_SB(b, h) ((4 + (b) * 2 + (h)) * HTB)
#define PG8_STAGE(bufoff, gbase, voff) do { _Pragma("unroll") for (int _i = 0; _i < 2; ++_i) \
        __builtin_amdgcn_global_load_lds((const unsigned*)((const char*)(gbase) + (voff)[_i]), (PG8_LAS unsigned*)(lds + (bufoff) + ldsw + _i * 8192), 16, 0, 0); } while (0)
#define PG8_LDA(dst, b, h) do { _Pragma("unroll") for (int m = 0; m < 4; ++m) _Pragma("unroll") for (int k = 0; k < 2; ++k) dst[m][k] = *(const PG8_LAS bf16x8*)(lds + PG8_SA(b, h) + aoff + m * 2048 + k * 1024); } while (0)
#define PG8_LDB(dst, b, h) do { _Pragma("unroll") for (int n = 0; n < 2; ++n) _Pragma("unroll") for (int k = 0; k < 2; ++k) dst[n][k] = *(const PG8_LAS bf16x8*)(lds + PG8_SB(b, h) + boff + n * 2048 + k * 1024); } while (0)
#define PG8_MMA(ai, bj, At, Bt) do { __builtin_amdgcn_s_setprio(1); _Pragma("unroll") for (int m = 0; m < 4; ++m) _Pragma("unroll") for (int n = 0; n < 2; ++n) _Pragma("unroll") for (int k = 0; k < 2; ++k) \
        acc[ai][bj][m][n] = __builtin_amdgcn_mfma_f32_16x16x32_bf16(Bt[n][k], At[m][k], acc[ai][bj][m][n], 0, 0, 0); __builtin_amdgcn_s_setprio(0); } while (0)
#define PG8_WAIT_V(n) asm volatile("s_waitcnt vmcnt(" #n ")" ::: "memory")
#define PG8_WAIT_L(n) asm volatile("s_waitcnt lgkmcnt(" #n ")" ::: "memory")
#define PG8_BAR __builtin_amdgcn_s_barrier()
#define PG8_SCHED __builtin_amdgcn_sched_barrier(0)
    Unit cur, nxt; int ui = 0;
    if (!S.next(0, cur)) return;
    Acc acc;
#pragma unroll
    for (int a = 0; a < 2; ++a)
#pragma unroll
        for (int b = 0; b < 2; ++b)
#pragma unroll
            for (int m = 0; m < 4; ++m)
#pragma unroll
                for (int n = 0; n < 2; ++n) acc[a][b][m][n] = (f32x4){0.f, 0.f, 0.f, 0.f};
    bf16x8 At[4][2], B0[2][2], B1[2][2];
    const char* cA = (const char*)g.A + (size_t)cur.pm * tA; const char* cB = (const char*)g.Bt + (size_t)cur.pn * tB;
    PG8_STAGE(PG8_SB(0, 0), cB, voffB); PG8_STAGE(PG8_SB(0, 1), cB + hB, voffB); PG8_STAGE(PG8_SA(0, 0), cA, voffA); PG8_STAGE(PG8_SA(0, 1), cA + hA, voffA);
    if (wr == 1) PG8_BAR;
    PG8_WAIT_V(2); PG8_BAR;
    PG8_STAGE(PG8_SB(1, 0), cB + kstep, voffB); PG8_STAGE(PG8_SA(1, 0), cA + kstep, voffA); PG8_STAGE(PG8_SB(1, 1), cB + hB + kstep, voffB);
    PG8_WAIT_V(6); PG8_BAR;
    for (;;) {
        const bool has_next = S.next(ui + 1, nxt);
        const char* nA = has_next ? (const char*)g.A + (size_t)nxt.pm * tA : cA; const char* nB = has_next ? (const char*)g.Bt + (size_t)nxt.pn * tB : cB;
#pragma unroll 1
        for (int t = 0; t < nt; t += 2) {
            const bool last = (t == nt - 2);
            const char* a1 = cA + (size_t)(t + 1) * kstep;
            const char* a2 = last ? nA : cA + (size_t)(t + 2) * kstep; const char* b2 = last ? nB : cB + (size_t)(t + 2) * kstep;
            const char* a3 = a2 + kstep; const char* b3 = b2 + kstep;
            PG8_LDB(B0, 0, 0); PG8_LDB(B1, 0, 1); PG8_SCHED; PG8_LDA(At, 0, 0); PG8_STAGE(PG8_SA(1, 1), a1 + hA, voffA);
            PG8_WAIT_V(8); PG8_WAIT_L(0); PG8_BAR; PG8_MMA(0, 0, At, B0); PG8_MMA(0, 1, At, B1); PG8_BAR; PG8_SCHED;
            PG8_LDA(At, 0, 1); PG8_STAGE(PG8_SB(0, 0), b2, voffB); PG8_STAGE(PG8_SB(0, 1), b2 + hB, voffB); PG8_STAGE(PG8_SA(0, 0), a2, voffA);
            PG8_WAIT_V(8); PG8_WAIT_L(0); PG8_BAR; PG8_MMA(1, 0, At, B0); PG8_MMA(1, 1, At, B1); PG8_BAR; PG8_SCHED;
            PG8_LDB(B0, 1, 0); PG8_LDB(B1, 1, 1); PG8_SCHED; PG8_LDA(At, 1, 0); PG8_STAGE(PG8_SA(0, 1), a2 + hA, voffA);
            PG8_WAIT_V(8); PG8_WAIT_L(0); PG8_BAR; PG8_MMA(0, 0, At, B0); PG8_MMA(0, 1, At, B1); PG8_BAR; PG8_SCHED;
            PG8_LDA(At, 1, 1); PG8_STAGE(PG8_SB(1, 0), b3, voffB); PG8_STAGE(PG8_SB(1, 1), b3 + hB, voffB); PG8_STAGE(PG8_SA(1, 0), a3, voffA);
            PG8_WAIT_V(8); PG8_WAIT_L(0); PG8_BAR; PG8_MMA(1, 0, At, B0); PG8_MMA(1, 1, At, B1); PG8_BAR; PG8_SCHED;
        }
        if constexpr (ALIGN_EPI) { if (wr == 0) PG8_BAR; }
        E(acc, cur, wr, wc, fr, fq);
        if (!has_next) break;
#pragma unroll
        for (int a = 0; a < 2; ++a)
#pragma unroll
            for (int b = 0; b < 2; ++b)
#pragma unroll
                for (int m = 0; m < 4; ++m)
#pragma unroll
                    for (int n = 0; n < 2; ++n) acc[a][b][m][n] = (f32x4){0.f, 0.f, 0.f, 0.f};
        cur = nxt; cA = nA; cB = nB; ++ui;
        if constexpr (ALIGN_EPI) { if (wr == 1) PG8_BAR; }
    }
    PG8_WAIT_V(0);
    if constexpr (!ALIGN_EPI) { if (wr == 0) PG8_BAR; }
    PG8_BAR;
#undef PG8_SA
#undef PG8_SB
#undef PG8_STAGE
#undef PG8_LDA
#undef PG8_LDB
#undef PG8_MMA
#undef PG8_WAIT_V
#undef PG8_WAIT_L
#undef PG8_BAR
#undef PG8_SCHED
}
}

namespace att {
using bf16 = unsigned short;
using bf16x8 = __attribute__((ext_vector_type(8))) short;
using s16x4 = __attribute__((ext_vector_type(4))) short;
using f32x16 = __attribute__((ext_vector_type(16))) float;
using u32x4 = __attribute__((ext_vector_type(4))) unsigned;
using i32x4 = __attribute__((ext_vector_type(4))) int;
constexpr int NW = 8, QBLK = 32, KVBLK = 64;
constexpr int SHM_V = 16384, SHM_K = 16384, SHM_KR = 8192;
constexpr int L_V = 0, L_K = 2 * SHM_V, L_KR = L_K + 2 * SHM_K, L_WS = L_KR + 2 * SHM_KR, L_KPOS = L_WS + NW * 64 * 4, L_BT = L_KPOS + 384 * 4, L_QR = L_BT + 2 * 260 * 4, L_END = L_QR + NW * 4096;
constexpr float THR2 = 8.f * LOG2E;
#define KSWZ(row, colB) ((row) * 256 + ((colB) ^ (((row) & 7) << 4)))
#define KRSWZ(row, colB) ((row) * 128 + ((colB) ^ ((((row) >> 1) & 7) << 4)))
#define SBAR() __builtin_amdgcn_sched_barrier(0)
__device__ __forceinline__ int crow(int r, int hi) { return (r & 3) + 8 * (r >> 2) + 4 * hi; }
__device__ __forceinline__ unsigned cvtpk(float lo, float hi) { unsigned r; asm volatile("v_cvt_pk_bf16_f32 %0, %1, %2" : "=v"(r) : "v"(lo), "v"(hi)); return r; }
__device__ __forceinline__ bf16x8 ld8(const bf16* p) { return *reinterpret_cast<const bf16x8*>(p); }

template <bool MASK>
__device__ __forceinline__ void partialSM(f32x16& p0, f32x16& p1, float& m_reg, float& mn, float& alpha, const int* kp, int qp, const float* bt, int hi) {
  if constexpr (MASK) {
#pragma unroll
    for (int g = 0; g < 4; ++g) { const i32x4 a = *(const i32x4*)(kp + 8 * g + 4 * hi), b = *(const i32x4*)(kp + 32 + 8 * g + 4 * hi);
#pragma unroll
      for (int j = 0; j < 4; ++j) { const int r = 4 * g + j;
        { const int idx = a[j] - qp + 128; const bool ok = (unsigned)idx <= 256u; const float bias = bt[ok ? idx : 0]; p0[r] = ok ? p0[r] + bias : -1e30f; }
        { const int idx = b[j] - qp + 128; const bool ok = (unsigned)idx <= 256u; const float bias = bt[ok ? idx : 0]; p1[r] = ok ? p1[r] + bias : -1e30f; } } }
  }
  float pmax = p0[0]; for (int r = 1; r < 16; ++r) pmax = fmaxf(pmax, p0[r]); for (int r = 0; r < 16; ++r) pmax = fmaxf(pmax, p1[r]);
  { auto rr = __builtin_amdgcn_permlane32_swap(__float_as_uint(pmax), __float_as_uint(pmax), false, false);
    pmax = fmaxf(__uint_as_float(rr[0]), __uint_as_float(rr[1])); }
  if (__builtin_expect(__all(pmax - m_reg <= THR2), 1)) { mn = m_reg; alpha = 1.f; }
  else { mn = fmaxf(m_reg, pmax); alpha = __builtin_amdgcn_exp2f(m_reg - mn); m_reg = mn; }
  for (int r = 0; r < 16; ++r) p0[r] = p0[r] - mn; for (int r = 0; r < 16; ++r) p1[r] = p1[r] - mn;
  for (int r = 0; r < 16; ++r) p0[r] = __builtin_amdgcn_exp2f(p0[r]);
}
__device__ __forceinline__ void finishSM(f32x16& p0, f32x16& p1, float alpha, float& l_reg, bf16x8& pa0, bf16x8& pa1, bf16x8& pa2, bf16x8& pa3) {
  for (int r = 0; r < 16; ++r) p1[r] = __builtin_amdgcn_exp2f(p1[r]);
  float ps = 0; for (int r = 0; r < 16; ++r) ps += p0[r]; for (int r = 0; r < 16; ++r) ps += p1[r];
  { auto rr = __builtin_amdgcn_permlane32_swap(__float_as_uint(ps), __float_as_uint(ps), false, false);
    ps = __uint_as_float(rr[0]) + __uint_as_float(rr[1]); }
  l_reg = l_reg * alpha + ps;
#define PK4(P, BASE, OUT) do { unsigned a0 = cvtpk(P[BASE + 0], P[BASE + 1]), a1 = cvtpk(P[BASE + 2], P[BASE + 3]);   \
    unsigned b0 = cvtpk(P[BASE + 4], P[BASE + 5]), b1 = cvtpk(P[BASE + 6], P[BASE + 7]);                              \
    auto r0 = __builtin_amdgcn_permlane32_swap(a0, b0, false, false); auto r1 = __builtin_amdgcn_permlane32_swap(a1, b1, false, false); \
    u32x4 w = {r0[0], r1[0], r0[1], r1[1]}; OUT = *reinterpret_cast<bf16x8*>(&w); } while (0)
  PK4(p0, 0, pa0); PK4(p0, 8, pa1); PK4(p1, 0, pa2); PK4(p1, 8, pa3);
#undef PK4
}
template <int NR>
__device__ __forceinline__ void qkt(f32x16& p0, f32x16& p1, const char* Ks, const char* Kr, const bf16x8* qr, const char* qrl, int r32, int hi) {
  p0 = f32x16{}; p1 = f32x16{};
#pragma unroll
  for (int d0 = 0; d0 < 8; ++d0) { const int cb = (d0 * 16 + hi * 8) * 2;
    const bf16x8 b0 = *reinterpret_cast<const bf16x8*>(Ks + KSWZ(r32, cb));
    const bf16x8 b1 = *reinterpret_cast<const bf16x8*>(Ks + KSWZ(32 + r32, cb));
    p0 = __builtin_amdgcn_mfma_f32_32x32x16_bf16(b0, qr[d0], p0, 0, 0, 0);
    p1 = __builtin_amdgcn_mfma_f32_32x32x16_bf16(b1, qr[d0], p1, 0, 0, 0); }
#pragma unroll
  for (int d0 = 0; d0 < NR; ++d0) { const int cb = (d0 * 16 + hi * 8) * 2;
    const bf16x8 b0 = *reinterpret_cast<const bf16x8*>(Kr + KRSWZ(r32, cb));
    const bf16x8 b1 = *reinterpret_cast<const bf16x8*>(Kr + KRSWZ(32 + r32, cb));
    const bf16x8 q = *reinterpret_cast<const bf16x8*>(qrl + d0 * 1024);
    p0 = __builtin_amdgcn_mfma_f32_32x32x16_bf16(b0, q, p0, 0, 0, 0);
    p1 = __builtin_amdgcn_mfma_f32_32x32x16_bf16(b1, q, p1, 0, 0, 0); }
}
__device__ __forceinline__ int v_st(int k, int c) { const int kk = (k & ~0xC) | ((k & 4) << 1) | ((k & 8) >> 1); return ((kk >> 3) * 4 + (c >> 5)) * 512 + ((kk & 7) * 32 + (c & 31)) * 2; }
__device__ __forceinline__ int v_rd_base(int lane) { return ((lane & 3) << 3) | (((lane >> 2) & 3) << 6) | (((lane >> 4) & 1) << 5) | (((lane >> 5) & 1) << 8); }
constexpr int v_rd_off(int d0, int ks, int half) { return d0 * 512 + ks * 4096 + half * 2048; }
template <int OFF> __device__ __forceinline__ s16x4 tr_read(int vb) {
  s16x4 r; asm volatile("ds_read_b64_tr_b16 %0, %1 offset:%2" : "=&v"(r) : "v"(vb), "i"(OFF) : "memory"); return r;
}
template <int D0> __device__ __forceinline__ void pv_one(f32x16& od, int vb, bf16x8 pa0, bf16x8 pa1, bf16x8 pa2, bf16x8 pa3) {
  const s16x4 l0 = tr_read<v_rd_off(D0, 0, 0)>(vb), h0 = tr_read<v_rd_off(D0, 0, 1)>(vb), l1 = tr_read<v_rd_off(D0, 1, 0)>(vb), h1 = tr_read<v_rd_off(D0, 1, 1)>(vb);
  const s16x4 l2 = tr_read<v_rd_off(D0, 2, 0)>(vb), h2 = tr_read<v_rd_off(D0, 2, 1)>(vb), l3 = tr_read<v_rd_off(D0, 3, 0)>(vb), h3 = tr_read<v_rd_off(D0, 3, 1)>(vb);
  asm volatile("s_waitcnt lgkmcnt(0)" ::: "memory"); SBAR();
#define PK(L, H) (bf16x8){L[0], L[1], L[2], L[3], H[0], H[1], H[2], H[3]}
  od = __builtin_amdgcn_mfma_f32_32x32x16_bf16(pa0, PK(l0, h0), od, 0, 0, 0);
  od = __builtin_amdgcn_mfma_f32_32x32x16_bf16(pa1, PK(l1, h1), od, 0, 0, 0);
  od = __builtin_amdgcn_mfma_f32_32x32x16_bf16(pa2, PK(l2, h2), od, 0, 0, 0);
  od = __builtin_amdgcn_mfma_f32_32x32x16_bf16(pa3, PK(l3, h3), od, 0, 0, 0);
#undef PK
}
__device__ __forceinline__ void pv_d0(f32x16* o, int vb, bf16x8 pa0, bf16x8 pa1, bf16x8 pa2, bf16x8 pa3) {
  pv_one<0>(o[0], vb, pa0, pa1, pa2, pa3); pv_one<1>(o[1], vb, pa0, pa1, pa2, pa3); pv_one<2>(o[2], vb, pa0, pa1, pa2, pa3); pv_one<3>(o[3], vb, pa0, pa1, pa2, pa3);
}

template <int MODE, int SDEPTH>
__device__ __forceinline__ void attn_unit(const bf16* Qw, const bf16* __restrict__ Kh, const bf16* __restrict__ Vh, const bf16* __restrict__ KRh,
                                          bf16* Ow, int NT_, char* lds, float m0, float l0, int qpos, const int* __restrict__ kposg, int nkeys, const float* __restrict__ btg) {
  constexpr int LD = MODE == 0 ? DM : 256, ldo = DM;
  const int NT = MODE == 0 ? SEQ / KVBLK : NT_;
  constexpr int NQ = 8, NR = MODE == 0 ? 4 : 0;
  int tid_ = threadIdx.x; asm volatile("" : "+v"(tid_));
  const int tid = tid_, wid = tid >> 6, lane = tid & 63, r32 = lane & 31, hi = lane >> 5;
  char* V_lds = lds + L_V; char* K_lds = lds + L_K; char* KR_lds = lds + L_KR;
  float* ws = (float*)(lds + L_WS) + wid * 64; float* li_l = ws; float* al_l = ws + 32;
  const int* kp_l = (const int*)(lds + L_KPOS); const float* bt_l = (const float*)(lds + L_BT) + (wid >> 2) * 260;
  __syncthreads();
  if constexpr (MODE == 1) {
    for (int i = tid; i < nkeys; i += 512) ((int*)(lds + L_KPOS))[i] = kposg[i];
    for (int i = tid; i < 520; i += 512) ((float*)(lds + L_BT))[i] = btg[i];
  }
  float m_reg = m0, l_reg = l0; f32x16 o[4] = {}; bf16x8 qr[NQ];
#pragma unroll
  for (int d0 = 0; d0 < NQ; ++d0) qr[d0] = ld8(Qw + d0 * 16);
  char* const qrl = lds + L_QR + wid * 4096 + hi * 512 + r32 * 16;
  if constexpr (MODE == 0) {
#pragma unroll
    for (int d0 = 0; d0 < 4; ++d0) *(bf16x8*)(qrl + d0 * 1024) = ld8(Qw + NOPE + d0 * 16);
  }
  const int sr = tid >> 4, sc = (tid & 15) * 8, vst0 = v_st(sr, sc), vst1 = v_st(32 + sr, sc);
  const int krr = tid >> 3, krc = (tid & 7) * 8;
  const int vb0 = (int)(uintptr_t)V_lds + v_rd_base(lane);
  struct { bf16x8 vs0, vs1, ks0, ks1, kr; } sr_[SDEPTH];
  const unsigned go0 = (unsigned)(sr * LD + sc), go1 = go0 + 32u * LD, gokr = (unsigned)(krr * ROPE + krc);
#define SLOAD(i, k0) do { const bf16* vt_ = Vh + (size_t)(k0) * LD; const bf16* kt_ = Kh + (size_t)(k0) * LD; \
    sr_[i].vs0 = ld8(vt_ + go0); sr_[i].vs1 = ld8(vt_ + go1); sr_[i].ks0 = ld8(kt_ + go0); sr_[i].ks1 = ld8(kt_ + go1); \
    if constexpr (MODE == 0) { const bf16* rt_ = KRh + (size_t)(k0) * ROPE; sr_[i].kr = ld8(rt_ + gokr); } } while (0)
#define SWRITE(b, i) do { *(bf16x8*)(V_lds + (b) * SHM_V + vst0) = sr_[i].vs0; *(bf16x8*)(V_lds + (b) * SHM_V + vst1) = sr_[i].vs1; const int kc = sc * 2; \
    *(bf16x8*)(K_lds + (b) * SHM_K + KSWZ(sr, kc)) = sr_[i].ks0; *(bf16x8*)(K_lds + (b) * SHM_K + KSWZ(32 + sr, kc)) = sr_[i].ks1; \
    if constexpr (MODE == 0) *(bf16x8*)(KR_lds + (b) * SHM_KR + KRSWZ(krr, krc * 2)) = sr_[i].kr; } while (0)
#define SWAIT() do { if constexpr (SDEPTH == 1) asm volatile("s_waitcnt vmcnt(0)" ::: "memory"); else if constexpr (MODE == 0) asm volatile("s_waitcnt vmcnt(5)" ::: "memory"); else asm volatile("s_waitcnt vmcnt(4)" ::: "memory"); } while (0)
#define RESC(a) do { if (__any((a) < 1.f)) { if (hi == 0) al_l[r32] = (a); asm volatile("s_waitcnt lgkmcnt(0)" ::: "memory"); \
    for (int d = 0; d < 4; ++d) for (int r = 0; r < 16; ++r) o[d][r] *= al_l[crow(r, hi)]; } } while (0)
  f32x16 pA0, pA1, pB0, pB1; float mnA, mnB, alA, alB; bf16x8 pa0, pa1, pa2, pa3;
  constexpr int SE = 0, SO = SDEPTH - 1;
  SLOAD(SE, 0); asm volatile("s_waitcnt vmcnt(0)" ::: "memory"); SWRITE(0, SE); __syncthreads();
  qkt<NR>(pA0, pA1, K_lds, KR_lds, qr, qrl, r32, hi); partialSM<MODE == 1>(pA0, pA1, m_reg, mnA, alA, kp_l, qpos, bt_l, hi);
  SLOAD(SO, KVBLK); if constexpr (SDEPTH == 2) { if (2 < NT) SLOAD(SE, 2 * KVBLK); }
  SWAIT(); SWRITE(1, SO); __syncthreads();
  for (int j = 1; j + 1 < NT; j += 2) {
    SBAR(); qkt<NR>(pB0, pB1, K_lds + SHM_K, KR_lds + SHM_KR, qr, qrl, r32, hi);
    finishSM(pA0, pA1, alA, l_reg, pa0, pa1, pa2, pa3); SBAR();
    SLOAD(SO, (j + SDEPTH) * KVBLK); SBAR();
    pv_d0(o, vb0, pa0, pa1, pa2, pa3); partialSM<MODE == 1>(pB0, pB1, m_reg, mnB, alB, kp_l + j * KVBLK, qpos, bt_l, hi);
    __syncthreads(); SWAIT(); SWRITE(0, SE);
    RESC(alB); __syncthreads();
    SBAR(); qkt<NR>(pA0, pA1, K_lds, KR_lds, qr, qrl, r32, hi);
    finishSM(pB0, pB1, alB, l_reg, pa0, pa1, pa2, pa3); SBAR();
    if (SDEPTH == 1 || j + 3 < NT) SLOAD(SE, (j + 1 + SDEPTH) * KVBLK); SBAR();
    pv_d0(o, vb0 + SHM_V, pa0, pa1, pa2, pa3); partialSM<MODE == 1>(pA0, pA1, m_reg, mnA, alA, kp_l + (j + 1) * KVBLK, qpos, bt_l, hi);
    __syncthreads(); SWAIT(); SWRITE(1, SO);
    RESC(alA); __syncthreads();
  }
  SBAR(); qkt<NR>(pB0, pB1, K_lds + SHM_K, KR_lds + SHM_KR, qr, qrl, r32, hi);
  finishSM(pA0, pA1, alA, l_reg, pa0, pa1, pa2, pa3); SBAR();
  pv_d0(o, vb0, pa0, pa1, pa2, pa3); partialSM<MODE == 1>(pB0, pB1, m_reg, mnB, alB, kp_l + (NT - 1) * KVBLK, qpos, bt_l, hi);
  __syncthreads(); RESC(alB);
  finishSM(pB0, pB1, alB, l_reg, pa0, pa1, pa2, pa3); SBAR();
  pv_d0(o, vb0 + SHM_V, pa0, pa1, pa2, pa3);
  if (hi == 0) li_l[r32] = l_reg; asm volatile("s_waitcnt lgkmcnt(0)" ::: "memory");
  float rli[16];
#pragma unroll
  for (int r = 0; r < 16; ++r) rli[r] = __builtin_amdgcn_rcpf(li_l[crow(r, hi)]);
#pragma unroll
  for (int r = 0; r < 16; ++r) { const int orow = crow(r, hi);
#pragma unroll
    for (int d0 = 0; d0 < 4; ++d0) { const float v = o[d0][r] * rli[r]; const unsigned u = __float_as_uint(v); Ow[(long)orow * ldo + d0 * 32 + r32] = (bf16)((u + 0x7fffu + ((u >> 16) & 1u)) >> 16); } }
#undef SLOAD
#undef SWRITE
#undef SWAIT
#undef RESC
}
#undef SBAR
}

constexpr int NWAVES = 8;
constexpr int N_LAUNCHES = MK_N_LAUNCHES;
constexpr int PER_PHASE = 12;
static_assert(N_LAUNCHES == 1 || N_LAUNCHES == PER_PHASE, "MK_N_LAUNCHES is 1 or 12");

constexpr size_t MiB = 1u << 20;
constexpr size_t WS_CTL = 0, CTL_ZERO_BYTES = 1 * MiB;
constexpr size_t CTL_SSQQ = 64 * 1024, CTL_SSQKV = 192 * 1024, CTL_MOD = 320 * 1024;
constexpr size_t WS_BT = 1 * MiB, WS_CS = 2 * MiB;
constexpr size_t WS_SMALL = 1 * MiB + 64 * 1024;
constexpr size_t WS_WIN = 10 * MiB, WS_WUQ = 19 * MiB, WS_WUKV = 21 * MiB, WS_WO2 = 22 * MiB, WS_WOUT = 26 * MiB, WS_W1 = 28 * MiB, WS_W2 = 36 * MiB;
constexpr size_t WS_XN = 44 * MiB;
constexpr size_t WS_KN = 44 * MiB;
constexpr size_t WS_QS = 108 * MiB;
constexpr size_t WS_KS = 172 * MiB, WS_VS = 188 * MiB, WS_KR = 204 * MiB;
constexpr size_t WS_GT = 208 * MiB;
constexpr size_t WS_LAT = 272 * MiB;
constexpr size_t WS_OA = 272 * MiB;
constexpr size_t WS_QM = 336 * MiB, WS_VM = 432 * MiB;
constexpr size_t WS_T = 336 * MiB, WS_MG = 400 * MiB;
constexpr size_t WS_X1 = 44 * MiB;
constexpr size_t WS_H2 = 172 * MiB;
constexpr size_t WS_U = 236 * MiB;
constexpr size_t WS_END = 496 * MiB;
constexpr int CW_BAR = 4096;

constexpr int RING_OFF = 0, RING_BYTES = 131072;
constexpr int LDSCTL_OFF = RING_BYTES, MISC_OFF = LDSCTL_OFF + 320;
constexpr int LDS_BYTES = 147456;
static_assert(att::L_END <= RING_BYTES, "attention LDS");

#define GAS __attribute__((address_space(1)))
#define LAS __attribute__((address_space(3)))
typedef unsigned short bf16;
typedef unsigned v4u __attribute__((ext_vector_type(4)));
typedef float f32x4 __attribute__((ext_vector_type(4)));
typedef GAS unsigned gu32;
#define RLX_AGENT __ATOMIC_RELAXED, __HIP_MEMORY_SCOPE_AGENT
#define LDS_WAIT() asm volatile("s_waitcnt lgkmcnt(0)" ::: "memory")
#define VM_WAIT() asm volatile("s_waitcnt vmcnt(0)" ::: "memory")
__device__ __forceinline__ unsigned f2bf(float f) { unsigned u = __builtin_bit_cast(unsigned, f); return (u + 0x7fffu + ((u >> 16) & 1u)) >> 16; }
__device__ __forceinline__ unsigned pk2(float lo, float hi) { return f2bf(lo) | (f2bf(hi) << 16); }

#define XB_TMO      128
#define XB_XCNT(j)  (256  + 64 * (j))
#define XB_XSUB(j)  (1280 + 64 * (j))
#define XB_XGEN(j)  (2304 + 64 * (j))
#define XB_TOP      3328
#define XB_TOPGEN   3392
#define XCD_BAR_WORDS 3456
#define XB_SPIN_CAP (1u << 18)
__device__ __forceinline__ unsigned xb_ld(unsigned* p)              { return __hip_atomic_load(p, __ATOMIC_RELAXED, __HIP_MEMORY_SCOPE_AGENT); }
__device__ __forceinline__ unsigned xb_add(unsigned* p, unsigned v) { return __hip_atomic_fetch_add(p, v, __ATOMIC_RELAXED, __HIP_MEMORY_SCOPE_AGENT); }
__device__ __forceinline__ unsigned xb_xcc_id() { return (unsigned)__builtin_amdgcn_s_getreg((3 << 11) | 20) & 0xFu; }
#define XB_SPIN(cond, bar) do { unsigned _sp = 0; while (cond) { __builtin_amdgcn_s_sleep(1); \
    if ((++_sp & 255u) == 0u) { if (xb_ld(&(bar)[XB_TMO])) break; if (_sp > XB_SPIN_CAP) { atomicAdd(&(bar)[XB_TMO], 1u); break; } } } } while (0)
struct XcdBarrier { unsigned* bar; unsigned x; volatile LAS unsigned* st; };
__device__ __forceinline__ XcdBarrier xcd_barrier_post(unsigned* bar, volatile LAS unsigned* st) {
    XcdBarrier b; b.bar = bar; b.x = xb_xcc_id(); b.st = st;
    if (threadIdx.x == 0) (void)xb_add(&bar[XB_XCNT(b.x)], 1u);
    return b;
}
__device__ __forceinline__ void xcd_barrier_complete(unsigned* bar, unsigned x, unsigned& nloc, unsigned& nx) {
    const unsigned G = gridDim.x * gridDim.y * gridDim.z;
    unsigned sum, cnt, mine, sp = 0u;
    for (;;) {
        sum = 0u; cnt = 0u; mine = 0u;
#pragma unroll
        for (unsigned j = 0; j < 16; ++j) { const unsigned c = xb_ld(&bar[XB_XCNT(j)]); sum += c; cnt += (c > 0u) ? 1u : 0u; mine = (j == x) ? c : mine; }
        if (sum == G) break;
        __builtin_amdgcn_s_sleep(1);
        if ((++sp & 255u) == 0u) { if (xb_ld(&bar[XB_TMO])) break; if (sp > XB_SPIN_CAP) { atomicAdd(&bar[XB_TMO], 1u); break; } }
    }
    nloc = mine > 0u ? mine : 1u; nx = cnt > 0u ? cnt : 1u;
}
__device__ __forceinline__ void xcd_barrier(const XcdBarrier& b) {
    asm volatile("s_waitcnt vmcnt(0)" ::: "memory");
    __syncthreads();
    if (threadIdx.x == 0) {
        unsigned* bar = b.bar;
        __builtin_amdgcn_s_waitcnt(0);
        unsigned nloc = b.st[0], nx = b.st[1];
        if (nloc == 0u) { xcd_barrier_complete(bar, b.x, nloc, nx); b.st[0] = nloc; b.st[1] = nx; }
        const unsigned old = xb_add(&bar[XB_XSUB(b.x)], 1u);
        const unsigned gen = old / nloc;
        if (old + 1u == (gen + 1u) * nloc) {
            __builtin_amdgcn_fence(__ATOMIC_RELEASE, "agent");
            asm volatile("s_waitcnt vmcnt(0)" ::: "memory");
            const unsigned og = xb_add(&bar[XB_TOP], 1u);
            const unsigned tg = og / nx;
            if (og + 1u == (tg + 1u) * nx) xb_add(&bar[XB_TOPGEN], 1u);
            else XB_SPIN(xb_ld(&bar[XB_TOPGEN]) == tg, bar);
            __builtin_amdgcn_fence(__ATOMIC_ACQUIRE, "agent");
            xb_add(&bar[XB_XGEN(b.x)], 1u);
            asm volatile("s_waitcnt vmcnt(0)" ::: "memory");
        } else {
            XB_SPIN(xb_ld(&bar[XB_XGEN(b.x)]) == gen, bar);
            __builtin_amdgcn_fence(__ATOMIC_ACQUIRE, "agent");
            asm volatile("s_waitcnt vmcnt(0)" ::: "memory");
        }
    }
    __syncthreads();
}

__device__ __forceinline__ float wave_sum(float v) {
#pragma unroll
    for (int o = 1; o < 64; o <<= 1) v += __shfl_xor(v, o);
    return v;
}
__device__ __forceinline__ int map_col(int mode, int n) {
    if (mode == 1) { if (n < 640) return n; if (n < 704) { const int i = n - 640; return 640 + (i < 32 ? 2 * i : 2 * (i - 32) + 1); } return n + 64; }
    if (mode == 2) { const int h = n / QKD, j = n % QKD; if (j < NOPE) return n; const int i = j - NOPE; return h * QKD + NOPE + (i < 32 ? 2 * i : 2 * (i - 32) + 1); }
    return n;
}
__device__ __forceinline__ void p0_transpose_item(const float* W, int K, int N, bf16* WT, int row_off, int mode, const float* kscale, LAS float* scr, int item, int lane) {
    const int nblk = N / 32, kb = item / nblk, nb = item % nblk, k0 = 64 * kb, n0 = 32 * nb;
#pragma unroll 8
    for (int i = 0; i < 32; ++i) { const int kk = 2 * i + (lane >> 5); float w = W[(size_t)(k0 + kk) * N + n0 + (lane & 31)]; if (kscale) w *= kscale[k0 + kk]; scr[kk * 33 + (lane & 31)] = w; }
    LDS_WAIT(); asm volatile("" ::: "memory");
    const int c = lane & 7;
#pragma unroll
    for (int j = 0; j < 4; ++j) { const int n = (lane >> 3) + 8 * j; const LAS float* s = scr + (8 * c) * 33 + n;
        v4u o; o.x = pk2(s[0 * 33], s[1 * 33]); o.y = pk2(s[2 * 33], s[3 * 33]); o.z = pk2(s[4 * 33], s[5 * 33]); o.w = pk2(s[6 * 33], s[7 * 33]);
        *(GAS v4u*)(WT + (size_t)(row_off + map_col(mode, n0 + n)) * K + k0 + 8 * c) = o; }
    LDS_WAIT(); asm volatile("" ::: "memory");
}
template <bool TO_BF16>
__device__ __forceinline__ void norm_row(const float* xrow, const float* gain, const float* msc, const float* msh, void* orow, int lane) {
    const GAS f32x4* xr = (const GAS f32x4*)xrow + lane;
    f32x4 v[4]; float s = 0.f;
#pragma unroll
    for (int j = 0; j < 4; ++j) { v[j] = xr[64 * j]; s += (v[j].x * v[j].x + v[j].y * v[j].y) + (v[j].z * v[j].z + v[j].w * v[j].w); }
    const float rstd = 1.f / sqrtf(wave_sum(s) * (1.f / DM) + EPS);
#pragma unroll
    for (int j = 0; j < 4; ++j) {
        f32x4 g = ((const GAS f32x4*)gain)[lane + 64 * j]; f32x4 y = v[j] * rstd * g;
        if (msc) { const f32x4 a = ((const GAS f32x4*)msc)[lane + 64 * j], b = ((const GAS f32x4*)msh)[lane + 64 * j]; y = y * (a + 1.f) + b; }
        if constexpr (TO_BF16) ((GAS unsigned long long*)orow)[lane + 64 * j] = (unsigned long long)pk2(y.x, y.y) | ((unsigned long long)pk2(y.z, y.w) << 32);
        else ((GAS f32x4*)orow)[lane + 64 * j] = y;
    }
}

struct Args { const float* in[20]; float* out; unsigned char* ws; int ph_lo, ph_hi, li, pad; };

__global__ void __launch_bounds__(NWAVES * 64, 2) fwd(Args args) {
    extern __shared__ __attribute__((aligned(16))) unsigned char lds[];
    LAS unsigned char* const L = (LAS unsigned char*)lds;
    volatile LAS unsigned* const MISC = (volatile LAS unsigned*)(L + MISC_OFF);
    const int tid = threadIdx.x, lane = tid & 63, wave = __builtin_amdgcn_readfirstlane(tid >> 6);
    const int G = gridDim.x; const int bx = blockIdx.x; const int vcu = (G % 8 == 0) ? (bx % 8) * (G / 8) + bx / 8 : bx;
    unsigned char* const ws = args.ws;
    gu32* const ctl = (gu32*)(ws + WS_CTL);
    const float* x = args.in[0]; const float* cvec = args.in[1]; const int* positions = (const int*)args.in[2];
    const float* w_ada = args.in[3]; const float* b_ada = args.in[4]; const float* norm_mix = args.in[5]; const float* w_in = args.in[6];
    const float* q_norm = args.in[7]; const float* w_uq = args.in[8]; const float* kv_norm = args.in[9]; const float* w_ukv = args.in[10];
    const float* rel_bias = args.in[11]; const float* sink = args.in[12]; const float* w_o_mla = args.in[13]; const float* w_o_swa = args.in[14];
    const float* w_out = args.in[15]; const float* norm_mlp = args.in[16]; const float* w_ff1 = args.in[17]; const float* w_ff2 = args.in[18]; const float* norm_final = args.in[19];
    float* const out = args.out;
    float* const SSQQ = (float*)(ws + CTL_SSQQ); float* const SSQKV = (float*)(ws + CTL_SSQKV); float* const MOD = (float*)(ws + CTL_MOD);
    float* const BT = (float*)(ws + WS_BT); float* const CS = (float*)(ws + WS_CS);
    float* const c_nmix = (float*)(ws + WS_SMALL); float* const c_nmlp = c_nmix + DM; float* const c_nfin = c_nmix + 2 * DM; float* const c_sink = c_nmix + 3 * DM; int* const c_pos = (int*)(ws + WS_SMALL + 16384);
    bf16* const Win_t = (bf16*)(ws + WS_WIN); bf16* const Wuq_t = (bf16*)(ws + WS_WUQ); bf16* const Wukv_t = (bf16*)(ws + WS_WUKV); bf16* const Wo2_t = (bf16*)(ws + WS_WO2);
    bf16* const Wout_t = (bf16*)(ws + WS_WOUT); bf16* const W1_t = (bf16*)(ws + WS_W1); bf16* const W2_t = (bf16*)(ws + WS_W2);
    bf16* const XN = (bf16*)(ws + WS_XN); bf16* const KN = (bf16*)(ws + WS_KN); bf16* const VM = (bf16*)(ws + WS_VM); bf16* const OA = (bf16*)(ws + WS_OA); bf16* const H2 = (bf16*)(ws + WS_H2);
    bf16* const QS = (bf16*)(ws + WS_QS); bf16* const KS = (bf16*)(ws + WS_KS); bf16* const VS = (bf16*)(ws + WS_VS); bf16* const KR = (bf16*)(ws + WS_KR);
    bf16* const LAT = (bf16*)(ws + WS_LAT); bf16* const QM = (bf16*)(ws + WS_QM);
    bf16* const TB = (bf16*)(ws + WS_T); bf16* const MG = (bf16*)(ws + WS_MG); bf16* const UB = (bf16*)(ws + WS_U);
    unsigned char* const GT = ws + WS_GT; float* const X1 = (float*)(ws + WS_X1);

    for (int u = tid; u < (LDS_BYTES - LDSCTL_OFF) / 4; u += NWAVES * 64) ((LAS unsigned*)(L + LDSCTL_OFF))[u] = 0u;
    __syncthreads();
    XcdBarrier bar; bar.bar = (unsigned*)(ctl + CW_BAR); bar.x = 0; bar.st = nullptr;
    if (N_LAUNCHES == 1) bar = xcd_barrier_post((unsigned*)(ctl + CW_BAR), MISC + 8);
#define GRID_BAR() do { if (N_LAUNCHES == 1) xcd_barrier(bar); } while (0)
    const int lo = args.ph_lo, hi = args.ph_hi;
#define IN(k) (lo <= (k) && (k) < hi)
#define BOTH(k) (IN(k) && IN((k) + 1))
    const int gw = vcu * NWAVES + wave, NGW = G * NWAVES;

    if (IN(0)) {
        LAS float* scr = (LAS float*)(L + RING_OFF + wave * 16384);
        constexpr int I_IN = (DM / 64) * (DIN / 32), I_UQ = (QL / 64) * (MH * QKD / 32), I_UKV = (KVL / 64) * (2048 / 32), I_O = (DM / 64) * (DM / 32), I_1 = (DM / 64) * (DFF / 32), I_2 = (DFF / 64) * (DM / 32);
        constexpr int NITEMS = I_IN + I_UQ + I_UKV + 3 * I_O + I_1 + I_2;
        for (int it = gw; it < NITEMS; it += NGW) {
            int r = it;
            if (r < I_IN) { p0_transpose_item(w_in, DM, DIN, Win_t, 0, 1, nullptr, scr, r, lane); continue; } r -= I_IN;
            if (r < I_UQ) { p0_transpose_item(w_uq, QL, MH * QKD, Wuq_t, 0, 2, q_norm, scr, r, lane); continue; } r -= I_UQ;
            if (r < I_UKV) { p0_transpose_item(w_ukv, KVL, 2048, Wukv_t, 0, 0, kv_norm, scr, r, lane); continue; } r -= I_UKV;
            if (r < I_O) { p0_transpose_item(w_o_mla, DM, DM, Wo2_t, 0, 0, nullptr, scr, r, lane); continue; } r -= I_O;
            if (r < I_O) { p0_transpose_item(w_o_swa, DM, DM, Wo2_t, DM, 0, nullptr, scr, r, lane); continue; } r -= I_O;
            if (r < I_O) { p0_transpose_item(w_out, DM, DM, Wout_t, 0, 0, nullptr, scr, r, lane); continue; } r -= I_O;
            if (r < I_1) { p0_transpose_item(w_ff1, DM, DFF, W1_t, 0, 0, nullptr, scr, r, lane); continue; } r -= I_1;
            p0_transpose_item(w_ff2, DFF, DM, W2_t, 0, 0, nullptr, scr, r, lane);
        }
        for (int i = bx * 512 + tid; i < 64 * DM / 8; i += G * 512) ((GAS v4u*)(Win_t + (size_t)704 * DM))[i] = (v4u){0u, 0u, 0u, 0u};
        for (int it = gw; it < 96 * 16; it += NGW) { const int cg = it % 96, ks = it / 96, n = cg * 64 + lane;
            float ca[8], a[8];
#pragma unroll
            for (int b = 0; b < 8; ++b) { const float cv = cvec[b * DM + ks * 64 + lane]; ca[b] = cv / (1.f + __expf(-cv)); a[b] = 0.f; }
#pragma unroll 8
            for (int kk = 0; kk < 64; ++kk) { const float w = w_ada[(size_t)(ks * 64 + kk) * NMOD + n];
#pragma unroll
                for (int b = 0; b < 8; ++b) a[b] += __uint_as_float(__builtin_amdgcn_readlane(__float_as_uint(ca[b]), kk)) * w; }
            const float bb = ks == 0 ? b_ada[n] : 0.f;
#pragma unroll
            for (int b = 0; b < 8; ++b) (void)__hip_atomic_fetch_add(MOD + b * NMOD + n, a[b] + bb, __ATOMIC_RELAXED, __HIP_MEMORY_SCOPE_AGENT);
        }
        for (int idx = bx * 512 + tid; idx < M * 32; idx += G * 512) { const int row = idx >> 5, i = idx & 31;
            const float inv = powf(10000.0f, -(float)(2 * i) / 64.0f); const float ang = (float)positions[row] * inv;
            const double ad = (double)ang; const double kq = rint(ad * 0.15915494309189535); const float rr = (float)(ad - kq * 6.283185307179586);
            CS[2 * idx] = cosf(rr); CS[2 * idx + 1] = sinf(rr); }
        for (int i = bx * 512 + tid; i < M; i += G * 512) c_pos[i] = positions[i];
        if (bx == 1) { for (int i = tid; i < DM; i += 512) { c_nmix[i] = norm_mix[i]; c_nmlp[i] = norm_mlp[i]; c_nfin[i] = norm_final[i]; } if (tid < SH) c_sink[tid] = sink[tid] * LOG2E; }
        if (bx == 0) for (int idx = tid; idx < SH * 257; idx += 512) { const int h = idx / 257, ri = idx % 257, rel = ri - 128, n = rel < 0 ? -rel : rel;
            int bk = n < 8 ? n : 8 + (31 - __clz(n * n)) - 6; if (n >= 8 && bk > 15) bk = 15; if (rel > 0) bk += 16;
            BT[h * 260 + ri] = rel_bias[bk * SH + h] * LOG2E; }
        if (BOTH(0)) GRID_BAR();
    }
    if (IN(1)) {
        int lane_ = lane; asm volatile("" : "+v"(lane_));
        for (int m = gw; m < M; m += NGW) { const float* mb = MOD + (size_t)(m / SEQ) * NMOD; norm_row<true>(x + (size_t)m * DM, c_nmix, mb + DM, mb, XN + (size_t)m * DM, lane_); }
        if (BOTH(1)) GRID_BAR();
    }
    if (IN(2)) {
        pg8::Gemm g{XN, Win_t, DM, DM}; pg8::StaticOrder S; S.init(M, DINP, G, bx);
        pg8::EpiProj E{LAT, KR, QS, KS, VS, GT, SSQQ, SSQKV, CS};
        pg8::gemm_phase<pg8::EpiProj, pg8::StaticOrder, true>(L + RING_OFF, g, S, E);
        if (BOTH(2)) GRID_BAR();
    }
    if (IN(3)) {
        { pg8::Gemm g{LAT, Wuq_t, LATP, QL}; pg8::StaticOrder S; S.init(M, MH * QKD, G, bx); pg8::EpiQ E{QM, SSQQ, CS};
          pg8::gemm_phase<pg8::EpiQ, pg8::StaticOrder, true>(L + RING_OFF, g, S, E); }
        { pg8::Gemm g{LAT + QL, Wukv_t, LATP, KVL}; pg8::StaticOrder S; S.init(M, 2048, G, bx); pg8::EpiKV E{KN, VM, SSQKV};
          pg8::gemm_phase<pg8::EpiKV, pg8::StaticOrder, true>(L + RING_OFF, g, S, E); }
        if (BOTH(3)) GRID_BAR();
    }
    if (IN(4)) {
        int lane_ = lane; asm volatile("" : "+v"(lane_));
        const int r32 = lane_ & 31, hi5 = lane_ >> 5;
        const int xg = vcu / 32, li = vcu % 32;
        for (int i = 0; i < 4; ++i) {
            const int b = xg, blk = li, kvh = i >> 1, hp = i & 1, h = kvh * 4 + hp * 2 + (wave >> 2);
            const int klo = blk * 128 - 128 < 0 ? 0 : blk * 128 - 128, khi = blk * 128 + 256 > SEQ ? SEQ : blk * 128 + 256, NT = (khi - klo) / 64;
            const int qrow = b * SEQ + blk * 128 + 32 * (wave & 3);
            const att::bf16* Qw = QS + (size_t)(qrow + r32) * DM + h * SHD + hi5 * 8;
            const att::bf16* Kh = KS + (size_t)(b * SEQ + klo) * 256 + kvh * SHD; const att::bf16* Vh = VS + (size_t)(b * SEQ + klo) * 256 + kvh * SHD;
            att::bf16* Ow = QS + (size_t)qrow * DM + h * SHD;
            att::attn_unit<1, 1>(Qw, Kh, Vh, nullptr, Ow, NT, (char*)lds + RING_OFF, c_sink[h], 1.f, c_pos[qrow + r32], c_pos + b * SEQ + klo, khi - klo, BT + (kvh * 4 + hp * 2) * 260);
        }
        for (int i = 0; i < 4; ++i) {
            const int b = xg, h = (li >> 4) * 4 + i, qb = li & 15;
            const int qrow = b * SEQ + qb * 256 + 32 * wave;
            const att::bf16* Qw = QM + (size_t)(qrow + r32) * (MH * QKD) + h * QKD + hi5 * 8;
            const att::bf16* Kh = KN + (size_t)(b * SEQ) * DM + h * NOPE; const att::bf16* Vh = VM + (size_t)(b * SEQ) * DM + h * VD; const att::bf16* KRh = KR + (size_t)(b * SEQ) * ROPE;
            att::bf16* Ow = OA + (size_t)qrow * DM + h * VD;
            att::attn_unit<0, 1>(Qw, Kh, Vh, KRh, Ow, SEQ / 64, (char*)lds + RING_OFF, -1e30f, 0.f, 0, nullptr, 0, nullptr);
        }
        __syncthreads();
        if (BOTH(4)) GRID_BAR();
    }
    if (IN(5)) {
        pg8::Gemm g{OA, Wo2_t, DM, DM}; pg8::StaticOrder S; S.init(M, DM, G, bx);
        pg8::EpiMerge E{GT, TB, MG, 0};
        pg8::gemm_phase<pg8::EpiMerge, pg8::StaticOrder, true>(L + RING_OFF, g, S, E);
        if (BOTH(5)) GRID_BAR();
    }
    if (IN(6)) {
        pg8::Gemm g{QS, Wo2_t + (size_t)DM * DM, DM, DM}; pg8::StaticOrder S; S.init(M, DM, G, bx);
        pg8::EpiMerge E{GT, TB, MG, 1};
        pg8::gemm_phase<pg8::EpiMerge, pg8::StaticOrder, true>(L + RING_OFF, g, S, E);
        if (BOTH(6)) GRID_BAR();
    }
    if (IN(7)) {
        pg8::Gemm g{MG, Wout_t, DM, DM}; pg8::StaticOrder S; S.init(M, DM, G, bx);
        pg8::EpiResid E{x, X1, MOD + 2 * DM};
        pg8::gemm_phase<pg8::EpiResid, pg8::StaticOrder, true>(L + RING_OFF, g, S, E);
        if (BOTH(7)) GRID_BAR();
    }
    if (IN(8)) {
        int lane_ = lane; asm volatile("" : "+v"(lane_));
        for (int m = gw; m < M; m += NGW) { const float* mb = MOD + (size_t)(m / SEQ) * NMOD; norm_row<true>(X1 + (size_t)m * DM, c_nmlp, mb + 4 * DM, mb + 3 * DM, H2 + (size_t)m * DM, lane_); }
        if (BOTH(8)) GRID_BAR();
    }
    if (IN(9)) {
        pg8::Gemm g{H2, W1_t, DM, DM}; pg8::StaticOrder S; S.init(M, DFF, G, bx);
        pg8::EpiRelu2 E{UB};
        pg8::gemm_phase<pg8::EpiRelu2, pg8::StaticOrder, true>(L + RING_OFF, g, S, E);
        if (BOTH(9)) GRID_BAR();
    }
    if (IN(10)) {
        pg8::Gemm g{UB, W2_t, DFF, DFF}; pg8::StaticOrder S; S.init(M, DM, G, bx);
        pg8::EpiResid E{X1, X1, MOD + 5 * DM};
        pg8::gemm_phase<pg8::EpiResid, pg8::StaticOrder, true>(L + RING_OFF, g, S, E);
        if (BOTH(10)) GRID_BAR();
    }
    if (IN(11)) {
        int lane_ = lane; asm volatile("" : "+v"(lane_));
        for (int m = gw; m < M; m += NGW) norm_row<false>(X1 + (size_t)m * DM, c_nfin, nullptr, nullptr, out + (size_t)m * DM, lane_);
        if (N_LAUNCHES == 1) {
            if (xb_ld((unsigned*)(ctl + CW_BAR) + XB_TMO) != 0u) { VM_WAIT(); __syncthreads(); const float q = __builtin_nanf("");
                for (int m = gw; m < M; m += NGW) { GAS f32x4* o = (GAS f32x4*)(out + (size_t)m * DM) + lane_;
#pragma unroll
                    for (int j = 0; j < 4; ++j) o[64 * j] = (f32x4){q, q, q, q}; } }
        }
    }
#undef IN
#undef BOTH
#undef GRID_BAR
}

extern "C" void kernel_launch(void* const* d_in, const int* in_sizes, int n_in, void* d_out, int out_size, void* d_ws, size_t ws_size, hipStream_t stream) {
    static int grid = 0;
    if (grid == 0) {
        if (n_in != 20 || in_sizes[0] != M * DM || out_size != M * DM || ws_size < WS_END) {
            fprintf(stderr, "kernel_launch: built for 20 inputs, x/out of %d floats, >= %zu bytes of workspace; got n_in %d, in0 %d, out %d, ws %zu; nothing launched\n", M * DM, (size_t)WS_END, n_in, n_in > 0 ? in_sizes[0] : -1, out_size, ws_size);
            grid = -1; return; }
        int dev = 0, cus = 0, per_cu = 0;
        if (hipGetDevice(&dev) != hipSuccess || hipDeviceGetAttribute(&cus, hipDeviceAttributeMultiprocessorCount, dev) != hipSuccess) { fprintf(stderr, "kernel_launch: device query failed\n"); grid = -1; return; }
        if (hipFuncSetAttribute((const void*)fwd, hipFuncAttributeMaxDynamicSharedMemorySize, LDS_BYTES) != hipSuccess) { fprintf(stderr, "kernel_launch: hipFuncSetAttribute failed\n"); grid = -1; return; }
        if (hipOccupancyMaxActiveBlocksPerMultiprocessor(&per_cu, (const void*)fwd, NWAVES * 64, LDS_BYTES) != hipSuccess || per_cu < 1)
            fprintf(stderr, "kernel_launch: note: occupancy query reports %d workgroups per CU\n", per_cu);
        (void)hipGetLastError();
        grid = cus;
        if (grid != 256) fprintf(stderr, "kernel_launch: note: %d CUs (the attention unit deal assumes 256)\n", grid);
    }
    if (grid < 0) return;
    if (hipMemsetAsync((char*)d_ws + WS_CTL, 0, CTL_ZERO_BYTES, stream) != hipSuccess) { fprintf(stderr, "kernel_launch: hipMemsetAsync failed\n"); return; }
    Args a{};
    for (int i = 0; i < 20; ++i) a.in[i] = (const float*)d_in[i];
    a.out = (float*)d_out; a.ws = (unsigned char*)d_ws;
    for (int li = 0; li < N_LAUNCHES; ++li) {
        a.ph_lo = (N_LAUNCHES == PER_PHASE) ? li : 0; a.ph_hi = (N_LAUNCHES == PER_PHASE) ? li + 1 : PER_PHASE; a.li = li;
        hipLaunchKernelGGL(fwd, dim3(grid), dim3(NWAVES * 64), LDS_BYTES, stream, a);
        const hipError_t le = hipPeekAtLastError();
        if (le != hipSuccess) { fprintf(stderr, "kernel_launch: launch %d failed: %s\n", li, hipGetErrorName(le)); break; }
    }
}
```

```cpp
#include <hip/hip_runtime.h>
#include <hip/hip_bf16.h>
#include <cstdio>
#include <cstdint>

#ifndef DBG_MIX_SCALE
#define DBG_MIX_SCALE 1.0f
#endif
#ifndef MK_N_LAUNCHES
#define MK_N_LAUNCHES 1
#endif

constexpr int BATCH = 8, SEQ = 4096, DM = 1024, M = BATCH * SEQ;
constexpr int QL = 384, KVL = 256, LATP = 640;
constexpr int MH = 8, NOPE = 128, ROPE = 64, QKD = NOPE + ROPE, VD = 128;
constexpr int SH = 8, SKVH = 2, SHD = 128;
constexpr int DFF = 4096, DIN = 4288, DINP = 4352, NMOD = 6 * DM;
constexpr float EPS = 1e-6f, LOG2E = 1.4426950408889634f;
constexpr float C2_MLA = 0.07216878364870323f * LOG2E;
constexpr float C2_SWA = 0.08838834764831845f * LOG2E;

namespace pg8 {
#define PG8_LAS __attribute__((address_space(3)))
typedef unsigned short bf16_t;
typedef short bf16x8 __attribute__((ext_vector_type(8)));
typedef float f32x4 __attribute__((ext_vector_type(4)));
typedef float f32x2 __attribute__((ext_vector_type(2)));
typedef unsigned u32x4 __attribute__((ext_vector_type(4)));
constexpr int BM = 256, BK = 64, HALF = 128, HTB = HALF * BK * 2, STAGE_BYTES = 8 * HTB, NXCD = 8, WGM = 8;

__host__ __device__ __forceinline__ int lds_byte(int r, int c) { const int st = (r >> 4) * 2 + (c >> 5), rr = r & 15, cc = c & 31, ob = rr * 64 + cc * 2; return st * 1024 + (ob ^ (((ob >> 9) & 1) << 5)); }
__host__ __device__ __forceinline__ void stage_rc(int b, int& R, int& C) { const int st = b / 1024, sb = b % 1024, swz = sb ^ (((sb >> 9) & 1) << 5); R = (st >> 1) * 16 + swz / 64; C = (st & 1) * 32 + (swz % 64) / 2; }
__host__ __device__ __forceinline__ int perm32(int rho) { const int n = rho >> 4, i = rho & 15; return 8 * (i >> 2) + 4 * n + (i & 3); }

struct Unit { int pm, pn; };
struct Gemm { const bf16_t* A; const bf16_t* Bt; int lda, K; };

struct StaticOrder {
    int nM, nN, nwg, G, c;
    __host__ __device__ void init(int M_, int N_, int G_, int c_) { nM = M_ / BM; nN = N_ / BM; nwg = nM * nN; G = G_; c = c_; }
    __host__ __device__ bool next(int i, Unit& u) const {
        const long L = (long)i * G + c; if (L >= nwg) return false;
        int wgid = (int)L; { const int q = nwg / NXCD, r = nwg % NXCD, xcd = wgid % NXCD, off = wgid / NXCD; wgid = (xcd < r ? xcd * (q + 1) : r * (q + 1) + (xcd - r) * q) + off; }
        const int nig = WGM * nN, gid = wgid / nig, fm = gid * WGM, gsz = (nM - fm) < WGM ? (nM - fm) : WGM;
        u.pm = fm + ((wgid % nig) % gsz); u.pn = (wgid % nig) / gsz; return true;
    }
};
struct PairOrder {
    StaticOrder so; int dpm;
    __host__ __device__ bool next(int i, Unit& u) const { Unit t; if (!so.next(i >> 1, t)) return false; const int s = i & 1; u.pm = t.pm + s * dpm; u.pn = t.pn + s * so.nN; return true; }
};

__device__ __forceinline__ unsigned cvt_pk_bf16(float lo, float hi) { unsigned r; asm volatile("v_cvt_pk_bf16_f32 %0, %1, %2" : "=v"(r) : "v"(lo), "v"(hi)); return r; }
__device__ __forceinline__ u32x4 pack8(const f32x4 a, const f32x4 b) { u32x4 w; w.x = cvt_pk_bf16(a[0], a[1]); w.y = cvt_pk_bf16(a[2], a[3]); w.z = cvt_pk_bf16(b[0], b[1]); w.w = cvt_pk_bf16(b[2], b[3]); return w; }
__device__ __forceinline__ void unpack8(const u32x4 w, f32x4& a, f32x4& b) {
    a[0] = __uint_as_float(w.x << 16); a[1] = __uint_as_float(w.x & 0xffff0000u); a[2] = __uint_as_float(w.y << 16); a[3] = __uint_as_float(w.y & 0xffff0000u);
    b[0] = __uint_as_float(w.z << 16); b[1] = __uint_as_float(w.z & 0xffff0000u); b[2] = __uint_as_float(w.w << 16); b[3] = __uint_as_float(w.w & 0xffff0000u); }

typedef f32x4 Acc[2][2][4][2];
typedef unsigned u32x2 __attribute__((ext_vector_type(2)));
__device__ __forceinline__ unsigned pack4_u8(const f32x4 g) {
    const unsigned a = (unsigned)__builtin_rintf(g[0] * 255.f), b = (unsigned)__builtin_rintf(g[1] * 255.f), c = (unsigned)__builtin_rintf(g[2] * 255.f), d = (unsigned)__builtin_rintf(g[3] * 255.f);
    return a | (b << 8) | (c << 16) | (d << 24); }
__device__ __forceinline__ f32x4 unpack4_u8(unsigned w) {
    f32x4 r; r[0] = (float)(w & 255u); r[1] = (float)((w >> 8) & 255u); r[2] = (float)((w >> 16) & 255u); r[3] = (float)(w >> 24); return r * (1.f / 255.f); }

struct EpiProj {
    bf16_t *LAT, *KR, *QS, *KS, *VS; unsigned char* GT; float *ssq_q, *ssq_kv; const float* cs;
    __device__ __forceinline__ void operator()(const Acc& acc, const Unit& u, int wr, int wc, int fr, int fq) const {
        const int pn = u.pn, row0 = u.pm * BM + wr * 64 + fr, cl = wc * 32 + 8 * fq;
        if (pn <= 2) {
#pragma unroll
            for (int bj = 0; bj < 2; ++bj) {
                const int gc = pn * 256 + bj * 128;
                if (gc < LATP) {
                    float* ssq = gc < QL ? ssq_q : ssq_kv;
#pragma unroll
                    for (int ai = 0; ai < 2; ++ai)
#pragma unroll
                        for (int m = 0; m < 4; ++m) { const int row = row0 + ai * HALF + m * 16; const f32x4 v0 = acc[ai][bj][m][0], v1 = acc[ai][bj][m][1];
                            float s = (v0[0] * v0[0] + v0[1] * v0[1]) + (v0[2] * v0[2] + v0[3] * v0[3]) + (v1[0] * v1[0] + v1[1] * v1[1]) + (v1[2] * v1[2] + v1[3] * v1[3]);
                            s += __shfl_xor(s, 16); s += __shfl_xor(s, 32);
                            if (fq == 0) (void)__hip_atomic_fetch_add(ssq + row, s, __ATOMIC_RELAXED, __HIP_MEMORY_SCOPE_AGENT);
                            *(u32x4*)(LAT + (size_t)row * LATP + gc + cl) = pack8(v0, v1); }
                } else if (wc < 2) {
#pragma unroll
                    for (int ai = 0; ai < 2; ++ai)
#pragma unroll
                        for (int m = 0; m < 4; ++m) { const int row = row0 + ai * HALF + m * 16; const f32x4 v0 = acc[ai][bj][m][0], v1 = acc[ai][bj][m][1];
                            const f32x4 c0 = *(const f32x4*)(cs + (size_t)row * 64 + cl), c1 = *(const f32x4*)(cs + (size_t)row * 64 + cl + 4);
                            f32x4 o0, o1;
                            o0[0] = v0[0] * c0[0] - v0[1] * c0[1]; o0[1] = v0[1] * c0[0] + v0[0] * c0[1]; o0[2] = v0[2] * c0[2] - v0[3] * c0[3]; o0[3] = v0[3] * c0[2] + v0[2] * c0[3];
                            o1[0] = v1[0] * c1[0] - v1[1] * c1[1]; o1[1] = v1[1] * c1[0] + v1[0] * c1[1]; o1[2] = v1[2] * c1[2] - v1[3] * c1[3]; o1[3] = v1[3] * c1[2] + v1[2] * c1[3];
                            *(u32x4*)(KR + (size_t)row * ROPE + cl) = pack8(o0, o1); }
                }
            }
        } else if (pn <= 8) {
            bf16_t* base; int ldc, colt; float sc = 1.f;
            if (pn <= 6) { base = QS; ldc = DM; colt = (pn - 3) * 256; sc = C2_SWA; } else if (pn == 7) { base = KS; ldc = 256; colt = 0; } else { base = VS; ldc = 256; colt = 0; }
#pragma unroll
            for (int ai = 0; ai < 2; ++ai)
#pragma unroll
                for (int m = 0; m < 4; ++m) { bf16_t* rowp = base + (size_t)(row0 + ai * HALF + m * 16) * ldc + colt + cl;
#pragma unroll
                    for (int bj = 0; bj < 2; ++bj) *(u32x4*)(rowp + bj * HALF) = pack8(acc[ai][bj][m][0] * sc, acc[ai][bj][m][1] * sc); }
        } else {
            const int colt = (pn - 9) * 256;
#pragma unroll
            for (int ai = 0; ai < 2; ++ai)
#pragma unroll
                for (int m = 0; m < 4; ++m) { unsigned char* rowp = GT + (size_t)(row0 + ai * HALF + m * 16) * 2048 + colt + cl;
#pragma unroll
                    for (int bj = 0; bj < 2; ++bj) { f32x4 v[2];
#pragma unroll
                        for (int n = 0; n < 2; ++n)
#pragma unroll
                            for (int j = 0; j < 4; ++j) v[n][j] = __builtin_amdgcn_rcpf(1.f + __builtin_amdgcn_exp2f(-LOG2E * acc[ai][bj][m][n][j]));
                        *(u32x2*)(rowp + bj * HALF) = (u32x2){pack4_u8(v[0]), pack4_u8(v[1])}; } }
        }
    }
};
struct EpiQ {
    bf16_t* Qm; const float* ssq_q; const float* cs;
    __device__ __forceinline__ void operator()(const Acc& acc, const Unit& u, int wr, int wc, int fr, int fq) const {
        const int row0 = u.pm * BM + wr * 64 + fr;
        float rs[2][4];
#pragma unroll
        for (int ai = 0; ai < 2; ++ai)
#pragma unroll
            for (int m = 0; m < 4; ++m) rs[ai][m] = __builtin_amdgcn_rsqf(ssq_q[row0 + ai * HALF + m * 16] * (1.f / QL) + EPS) * C2_MLA;
#pragma unroll
        for (int bj = 0; bj < 2; ++bj) {
            const int gc = u.pn * 256 + bj * 128 + wc * 32, j0 = gc % QKD; const bool rope = j0 >= NOPE; const int p0 = (j0 - NOPE) + 8 * fq;
            if (rope) {
#pragma unroll
                for (int ai = 0; ai < 2; ++ai) { f32x4 c0[4], c1[4];
#pragma unroll
                    for (int m = 0; m < 4; ++m) { const int row = row0 + ai * HALF + m * 16; c0[m] = *(const f32x4*)(cs + (size_t)row * 64 + p0); c1[m] = *(const f32x4*)(cs + (size_t)row * 64 + p0 + 4); }
#pragma unroll
                    for (int m = 0; m < 4; ++m) { const int row = row0 + ai * HALF + m * 16; const f32x4 v0 = acc[ai][bj][m][0] * rs[ai][m], v1 = acc[ai][bj][m][1] * rs[ai][m]; f32x4 o0, o1;
                        o0[0] = v0[0] * c0[m][0] - v0[1] * c0[m][1]; o0[1] = v0[1] * c0[m][0] + v0[0] * c0[m][1]; o0[2] = v0[2] * c0[m][2] - v0[3] * c0[m][3]; o0[3] = v0[3] * c0[m][2] + v0[2] * c0[m][3];
                        o1[0] = v1[0] * c1[m][0] - v1[1] * c1[m][1]; o1[1] = v1[1] * c1[m][0] + v1[0] * c1[m][1]; o1[2] = v1[2] * c1[m][2] - v1[3] * c1[m][3]; o1[3] = v1[3] * c1[m][2] + v1[2] * c1[m][3];
                        *(u32x4*)(Qm + (size_t)row * (MH * QKD) + gc + 8 * fq) = pack8(o0, o1); } }
            } else {
#pragma unroll
                for (int ai = 0; ai < 2; ++ai)
#pragma unroll
                    for (int m = 0; m < 4; ++m) { const int row = row0 + ai * HALF + m * 16;
                        *(u32x4*)(Qm + (size_t)row * (MH * QKD) + gc + 8 * fq) = pack8(acc[ai][bj][m][0] * rs[ai][m], acc[ai][bj][m][1] * rs[ai][m]); }
            }
        }
    }
};
struct EpiKV {
    bf16_t* KN; bf16_t* VM; const float* ssq_kv;
    __device__ __forceinline__ void operator()(const Acc& acc, const Unit& u, int wr, int wc, int fr, int fq) const {
        const int row0 = u.pm * BM + wr * 64 + fr, col0 = u.pn * HALF + wc * 32 + 8 * fq;
#pragma unroll
        for (int ai = 0; ai < 2; ++ai)
#pragma unroll
            for (int m = 0; m < 4; ++m) { const int row = row0 + ai * HALF + m * 16; const float rs = __builtin_amdgcn_rsqf(ssq_kv[row] * (1.f / KVL) + EPS);
#pragma unroll
                for (int bj = 0; bj < 2; ++bj) *(u32x4*)((bj ? VM : KN) + (size_t)row * DM + col0) = pack8(acc[ai][bj][m][0] * rs, acc[ai][bj][m][1] * rs); }
    }
};
struct EpiMerge {
    const unsigned char* GT; bf16_t* T; bf16_t* MG; int dpm, nN;
    __device__ __forceinline__ void operator()(const Acc& acc, const Unit& u, int wr, int wc, int fr, int fq) const {
        const int s = u.pn >= nN ? 1 : 0, pm = u.pm - s * dpm, pn = u.pn - s * nN;
        const int row0 = pm * BM + wr * 64 + fr, col0 = pn * BM + wc * 32 + 8 * fq;
#pragma unroll
        for (int ai = 0; ai < 2; ++ai)
#pragma unroll
            for (int mh = 0; mh < 2; ++mh) {
                u32x2 gw[2][2];
#pragma unroll
                for (int mm = 0; mm < 2; ++mm)
#pragma unroll
                    for (int bj = 0; bj < 2; ++bj) gw[mm][bj] = *(const u32x2*)(GT + (size_t)(row0 + ai * HALF + (2 * mh + mm) * 16) * 2048 + s * DM + col0 + bj * HALF);
                if (s == 0) {
#pragma unroll
                    for (int mm = 0; mm < 2; ++mm)
#pragma unroll
                        for (int bj = 0; bj < 2; ++bj) { const int m = 2 * mh + mm;
                            *(u32x4*)(T + (size_t)(row0 + ai * HALF + m * 16) * DM + col0 + bj * HALF) = pack8(acc[ai][bj][m][0] * unpack4_u8(gw[mm][bj].x), acc[ai][bj][m][1] * unpack4_u8(gw[mm][bj].y)); }
                } else {
                    u32x4 tw[2][2];
#pragma unroll
                    for (int mm = 0; mm < 2; ++mm)
#pragma unroll
                        for (int bj = 0; bj < 2; ++bj) tw[mm][bj] = *(const u32x4*)(T + (size_t)(row0 + ai * HALF + (2 * mh + mm) * 16) * DM + col0 + bj * HALF);
#pragma unroll
                    for (int mm = 0; mm < 2; ++mm)
#pragma unroll
                        for (int bj = 0; bj < 2; ++bj) { const int m = 2 * mh + mm; f32x4 t0, t1; unpack8(tw[mm][bj], t0, t1);
                            *(u32x4*)(MG + (size_t)(row0 + ai * HALF + m * 16) * DM + col0 + bj * HALF) = pack8(acc[ai][bj][m][0] * unpack4_u8(gw[mm][bj].x) + t0, acc[ai][bj][m][1] * unpack4_u8(gw[mm][bj].y) + t1); }
                }
                asm volatile("" ::: "memory");
            }
    }
};
struct EpiResid {
    const float* base; float* out; const float* gmod;
    bf16_t* XG; const float* gcol; float* ssq;
    __device__ __forceinline__ void operator()(const Acc& acc, const Unit& u, int wr, int wc, int fr, int fq) const {
        const int row0 = u.pm * BM + wr * 64 + fr, col0 = u.pn * BM + wc * 32 + 8 * fq; const int b = (u.pm * BM) / SEQ; const float* gb = gmod + (size_t)b * NMOD;
        f32x4 gv[2][2], gc[2][2];
#pragma unroll
        for (int bj = 0; bj < 2; ++bj)
#pragma unroll
            for (int n = 0; n < 2; ++n) { gv[bj][n] = *(const f32x4*)(gb + col0 + bj * HALF + 4 * n); if (XG) gc[bj][n] = *(const f32x4*)(gcol + (size_t)b * DM + col0 + bj * HALF + 4 * n); }
#pragma unroll
        for (int ai = 0; ai < 2; ++ai)
#pragma unroll
            for (int m = 0; m < 4; ++m) { const int row = row0 + ai * HALF + m * 16; const size_t off = (size_t)row * DM + col0; float sq = 0.f;
#pragma unroll
                for (int bj = 0; bj < 2; ++bj) { f32x4 o[2];
#pragma unroll
                    for (int n = 0; n < 2; ++n) { const f32x4 bs = *(const f32x4*)(base + off + bj * HALF + 4 * n); o[n] = bs + gv[bj][n] * acc[ai][bj][m][n]; *(f32x4*)(out + off + bj * HALF + 4 * n) = o[n]; }
                    if (XG) { sq += (o[0][0] * o[0][0] + o[0][1] * o[0][1]) + (o[0][2] * o[0][2] + o[0][3] * o[0][3]) + (o[1][0] * o[1][0] + o[1][1] * o[1][1]) + (o[1][2] * o[1][2] + o[1][3] * o[1][3]);
                        *(u32x4*)(XG + off + bj * HALF) = pack8(o[0] * gc[bj][0], o[1] * gc[bj][1]); } }
                if (XG) { sq += __shfl_xor(sq, 16); sq += __shfl_xor(sq, 32); if (fq == 0) (void)__hip_atomic_fetch_add(ssq + row, sq, __ATOMIC_RELAXED, __HIP_MEMORY_SCOPE_AGENT); }
                if (m & 1) asm volatile("" ::: "memory"); }
    }
};
struct EpiRelu2 {
    bf16_t* U; const float* ssq; const float* cvec;
    __device__ __forceinline__ void operator()(const Acc& acc, const Unit& u, int wr, int wc, int fr, int fq) const {
        const int row0 = u.pm * BM + wr * 64 + fr, col0 = u.pn * BM + wc * 32 + 8 * fq; const float* cb = cvec + (size_t)((u.pm * BM) / SEQ) * DFF;
        f32x4 cv[2][2];
#pragma unroll
        for (int bj = 0; bj < 2; ++bj)
#pragma unroll
            for (int n = 0; n < 2; ++n) cv[bj][n] = *(const f32x4*)(cb + col0 + bj * HALF + 4 * n);
#pragma unroll
        for (int ai = 0; ai < 2; ++ai)
#pragma unroll
            for (int m = 0; m < 4; ++m) { const int row = row0 + ai * HALF + m * 16; bf16_t* rowp = U + (size_t)row * DFF + col0;
                const float rs = __builtin_amdgcn_rsqf(ssq[row] * (1.f / DM) + EPS);
#pragma unroll
                for (int bj = 0; bj < 2; ++bj) { f32x4 v[2];
#pragma unroll
                    for (int n = 0; n < 2; ++n)
#pragma unroll
                        for (int j = 0; j < 4; ++j) { const float r = fmaxf(acc[ai][bj][m][n][j] * rs + cv[bj][n][j], 0.f); v[n][j] = r * r; }
                    *(u32x4*)(rowp + bj * HALF) = pack8(v[0], v[1]); } }
    }
};

template <class Epi, class Sched, bool ALIGN_EPI>
__device__ __forceinline__ void gemm_phase(PG8_LAS unsigned char* lds, const Gemm g, const Sched& S, const Epi& E) {
    int tid_ = threadIdx.x; asm volatile("" : "+v"(tid_));
    const int tid = tid_, wid = __builtin_amdgcn_readfirstlane(tid >> 6), lane = tid & 63, wr = wid >> 2, wc = wid & 3, fr = lane & 15, fq = lane >> 4;
    const int K = g.K, nt = K / BK;
    unsigned voffA[2], voffB[2];
#pragma unroll
    for (int i = 0; i < 2; ++i) { int R, C; stage_rc(tid * 16 + i * 8192, R, C); const int Rb = (R & ~31) + perm32(R & 31);
        voffA[i] = (unsigned)(R * g.lda + C) * 2u; voffB[i] = (unsigned)(Rb * K + C) * 2u; }
    const size_t kstep = (size_t)(BK * 2);
    const size_t hA = (size_t)HALF * g.lda * 2, hB = (size_t)HALF * K * 2, tA = 2 * hA, tB = 2 * hB;
    const unsigned ldsw = (unsigned)wid * 1024u;
    const int aoff = lds_byte(wr * 64 + fr, fq * 8), boff = lds_byte(wc * 32 + fr, fq * 8);
#define PG8_SA(b, h) (((b) * 2 + (h)) * HTB)
#define PG8_SB(b, h) ((4 + (b) * 2 + (h)) * HTB)
#define PG8_STAGE(bufoff, gbase, voff) do { _Pragma("unroll") for (int _i = 0; _i < 2; ++_i) \
        __builtin_amdgcn_global_load_lds((const unsigned*)((const char*)(gbase) + (voff)[_i]), (PG8_LAS unsigned*)(lds + (bufoff) + ldsw + _i * 8192), 16, 0, 0); } while (0)
#define PG8_LDA(dst, b, h) do { _Pragma("unroll") for (int m = 0; m < 4; ++m) _Pragma("unroll") for (int k = 0; k < 2; ++k) dst[m][k] = *(const PG8_LAS bf16x8*)(lds + PG8_SA(b, h) + aoff + m * 2048 + k * 1024); } while (0)
#define PG8_LDB(dst, b, h) do { _Pragma("unroll") for (int n = 0; n < 2; ++n) _Pragma("unroll") for (int k = 0; k < 2; ++k) dst[n][k] = *(const PG8_LAS bf16x8*)(lds + PG8_SB(b, h) + boff + n * 2048 + k * 1024); } while (0)
#define PG8_MMA(ai, bj, At, Bt) do { __builtin_amdgcn_s_setprio(1); _Pragma("unroll") for (int m = 0; m < 4; ++m) _Pragma("unroll") for (int n = 0; n < 2; ++n) _Pragma("unroll") for (int k = 0; k < 2; ++k) \
        acc[ai][bj][m][n] = __builtin_amdgcn_mfma_f32_16x16x32_bf16(Bt[n][k], At[m][k], acc[ai][bj][m][n], 0, 0, 0); __builtin_amdgcn_s_setprio(0); } while (0)
#define PG8_WAIT_V(n) asm volatile("s_waitcnt vmcnt(" #n ")" ::: "memory")
#define PG8_WAIT_L(n) asm volatile("s_waitcnt lgkmcnt(" #n ")" ::: "memory")
#define PG8_BAR __builtin_amdgcn_s_barrier()
#define PG8_SCHED __builtin_amdgcn_sched_barrier(0)
    Unit cur, nxt; int ui = 0;
    if (!S.next(0, cur)) return;
    Acc acc;
#pragma unroll
    for (int a = 0; a < 2; ++a)
#pragma unroll
        for (int b = 0; b < 2; ++b)
#pragma unroll
            for (int m = 0; m < 4; ++m)
#pragma unroll
                for (int n = 0; n < 2; ++n) acc[a][b][m][n] = (f32x4){0.f, 0.f, 0.f, 0.f};
    bf16x8 At[4][2], B0[2][2], B1[2][2];
    const char* cA = (const char*)g.A + (size_t)cur.pm * tA; const char* cB = (const char*)g.Bt + (size_t)cur.pn * tB;
    PG8_STAGE(PG8_SB(0, 0), cB, voffB); PG8_STAGE(PG8_SB(0, 1), cB + hB, voffB); PG8_STAGE(PG8_SA(0, 0), cA, voffA); PG8_STAGE(PG8_SA(0, 1), cA + hA, voffA);
    if (wr == 1) PG8_BAR;
    PG8_WAIT_V(2); PG8_BAR;
    PG8_STAGE(PG8_SB(1, 0), cB + kstep, voffB); PG8_STAGE(PG8_SA(1, 0), cA + kstep, voffA); PG8_STAGE(PG8_SB(1, 1), cB + hB + kstep, voffB);
    PG8_WAIT_V(6); PG8_BAR;
    for (;;) {
        const bool has_next = S.next(ui + 1, nxt);
        const char* nA = has_next ? (const char*)g.A + (size_t)nxt.pm * tA : cA; const char* nB = has_next ? (const char*)g.Bt + (size_t)nxt.pn * tB : cB;
#pragma unroll 1
        for (int t = 0; t < nt; t += 2) {
            const bool last = (t == nt - 2);
            const char* a1 = cA + (size_t)(t + 1) * kstep;
            const char* a2 = last ? nA : cA + (size_t)(t + 2) * kstep; const char* b2 = last ? nB : cB + (size_t)(t + 2) * kstep;
            const char* a3 = a2 + kstep; const char* b3 = b2 + kstep;
            PG8_LDB(B0, 0, 0); PG8_LDB(B1, 0, 1); PG8_SCHED; PG8_LDA(At, 0, 0); PG8_STAGE(PG8_SA(1, 1), a1 + hA, voffA);
            PG8_WAIT_V(8); PG8_WAIT_L(0); PG8_BAR; PG8_MMA(0, 0, At, B0); PG8_MMA(0, 1, At, B1); PG8_BAR; PG8_SCHED;
            PG8_LDA(At, 0, 1); PG8_STAGE(PG8_SB(0, 0), b2, voffB); PG8_STAGE(PG8_SB(0, 1), b2 + hB, voffB); PG8_STAGE(PG8_SA(0, 0), a2, voffA);
            PG8_WAIT_V(8); PG8_WAIT_L(0); PG8_BAR; PG8_MMA(1, 0, At, B0); PG8_MMA(1, 1, At, B1); PG8_BAR; PG8_SCHED;
            PG8_LDB(B0, 1, 0); PG8_LDB(B1, 1, 1); PG8_SCHED; PG8_LDA(At, 1, 0); PG8_STAGE(PG8_SA(0, 1), a2 + hA, voffA);
            PG8_WAIT_V(8); PG8_WAIT_L(0); PG8_BAR; PG8_MMA(0, 0, At, B0); PG8_MMA(0, 1, At, B1); PG8_BAR; PG8_SCHED;
            PG8_LDA(At, 1, 1); PG8_STAGE(PG8_SB(1, 0), b3, voffB); PG8_STAGE(PG8_SB(1, 1), b3 + hB, voffB); PG8_STAGE(PG8_SA(1, 0), a3, voffA);
            PG8_WAIT_V(8); PG8_WAIT_L(0); PG8_BAR; PG8_MMA(1, 0, At, B0); PG8_MMA(1, 1, At, B1); PG8_BAR; PG8_SCHED;
        }
        if constexpr (ALIGN_EPI) { if (wr == 0) PG8_BAR; }
        E(acc, cur, wr, wc, fr, fq);
        if (!has_next) break;
#pragma unroll
        for (int a = 0; a < 2; ++a)
#pragma unroll
            for (int b = 0; b < 2; ++b)
#pragma unroll
                for (int m = 0; m < 4; ++m)
#pragma unroll
                    for (int n = 0; n < 2; ++n) acc[a][b][m][n] = (f32x4){0.f, 0.f, 0.f, 0.f};
        cur = nxt; cA = nA; cB = nB; ++ui;
        if constexpr (ALIGN_EPI) { if (wr == 1) PG8_BAR; }
    }
    PG8_WAIT_V(0);
    if constexpr (!ALIGN_EPI) { if (wr == 0) PG8_BAR; }
    PG8_BAR;
#undef PG8_SA
#undef PG8_SB
#undef PG8_STAGE
#undef PG8_LDA
#undef PG8_LDB
#undef PG8_MMA
#undef PG8_WAIT_V
#undef PG8_WAIT_L
#undef PG8_BAR
#undef PG8_SCHED
}
}

namespace att {
using bf16 = unsigned short;
using bf16x8 = __attribute__((ext_vector_type(8))) short;
using s16x4 = __attribute__((ext_vector_type(4))) short;
using f32x16 = __attribute__((ext_vector_type(16))) float;
using u32x4 = __attribute__((ext_vector_type(4))) unsigned;
using i32x4 = __attribute__((ext_vector_type(4))) int;
constexpr int NW = 8, QBLK = 32, KVBLK = 64;
constexpr int SHM_V = 16384, SHM_K = 16384, SHM_KR = 8192;
constexpr int L_V = 0, L_K = 2 * SHM_V, L_KR = L_K + 2 * SHM_K, L_WS = L_KR + 2 * SHM_KR, L_KPOS = L_WS + NW * 64 * 4, L_BT = L_KPOS + 384 * 4, L_QR = L_BT + 2 * 260 * 4, L_END = L_QR + NW * 4096;
constexpr float THR2 = 8.f * LOG2E;
#define KSWZ(row, colB) ((row) * 256 + ((colB) ^ (((row) & 7) << 4)))
#define KRSWZ(row, colB) ((row) * 128 + ((colB) ^ ((((row) >> 1) & 7) << 4)))
#define SBAR() __builtin_amdgcn_sched_barrier(0)
__device__ __forceinline__ int crow(int r, int hi) { return (r & 3) + 8 * (r >> 2) + 4 * hi; }
__device__ __forceinline__ unsigned cvtpk(float lo, float hi) { unsigned r; asm volatile("v_cvt_pk_bf16_f32 %0, %1, %2" : "=v"(r) : "v"(lo), "v"(hi)); return r; }
__device__ __forceinline__ bf16x8 ld8(const bf16* p) { return *reinterpret_cast<const bf16x8*>(p); }

template <bool MASK>
__device__ __forceinline__ void partialSM(f32x16& p0, f32x16& p1, float& m_reg, float& mn, float& alpha, const int* kp, int qp, const float* bt, int hi) {
  if constexpr (MASK) {
#pragma unroll
    for (int g = 0; g < 4; ++g) { const i32x4 a = *(const i32x4*)(kp + 8 * g + 4 * hi), b = *(const i32x4*)(kp + 32 + 8 * g + 4 * hi);
#pragma unroll
      for (int j = 0; j < 4; ++j) { const int r = 4 * g + j;
        { const int idx = a[j] - qp + 128; const bool ok = (unsigned)idx <= 256u; const float bias = bt[ok ? idx : 0]; p0[r] = ok ? p0[r] + bias : -1e30f; }
        { const int idx = b[j] - qp + 128; const bool ok = (unsigned)idx <= 256u; const float bias = bt[ok ? idx : 0]; p1[r] = ok ? p1[r] + bias : -1e30f; } } }
  }
  float pmax = p0[0]; for (int r = 1; r < 16; ++r) pmax = fmaxf(pmax, p0[r]); for (int r = 0; r < 16; ++r) pmax = fmaxf(pmax, p1[r]);
  { auto rr = __builtin_amdgcn_permlane32_swap(__float_as_uint(pmax), __float_as_uint(pmax), false, false);
    pmax = fmaxf(__uint_as_float(rr[0]), __uint_as_float(rr[1])); }
  if (__builtin_expect(__all(pmax - m_reg <= THR2), 1)) { mn = m_reg; alpha = 1.f; }
  else { mn = fmaxf(m_reg, pmax); alpha = __builtin_amdgcn_exp2f(m_reg - mn); m_reg = mn; }
  for (int r = 0; r < 16; ++r) p0[r] = p0[r] - mn; for (int r = 0; r < 16; ++r) p1[r] = p1[r] - mn;
  for (int r = 0; r < 16; ++r) p0[r] = __builtin_amdgcn_exp2f(p0[r]);
}
__device__ __forceinline__ void finishSM(f32x16& p0, f32x16& p1, float alpha, float& l_reg, bf16x8& pa0, bf16x8& pa1, bf16x8& pa2, bf16x8& pa3) {
  for (int r = 0; r < 16; ++r) p1[r] = __builtin_amdgcn_exp2f(p1[r]);
  float ps = 0; for (int r = 0; r < 16; ++r) ps += p0[r]; for (int r = 0; r < 16; ++r) ps += p1[r];
  { auto rr = __builtin_amdgcn_permlane32_swap(__float_as_uint(ps), __float_as_uint(ps), false, false);
    ps = __uint_as_float(rr[0]) + __uint_as_float(rr[1]); }
  l_reg = l_reg * alpha + ps;
#define PK4(P, BASE, OUT) do { unsigned a0 = cvtpk(P[BASE + 0], P[BASE + 1]), a1 = cvtpk(P[BASE + 2], P[BASE + 3]);   \
    unsigned b0 = cvtpk(P[BASE + 4], P[BASE + 5]), b1 = cvtpk(P[BASE + 6], P[BASE + 7]);                              \
    auto r0 = __builtin_amdgcn_permlane32_swap(a0, b0, false, false); auto r1 = __builtin_amdgcn_permlane32_swap(a1, b1, false, false); \
    u32x4 w = {r0[0], r1[0], r0[1], r1[1]}; OUT = *reinterpret_cast<bf16x8*>(&w); } while (0)
  PK4(p0, 0, pa0); PK4(p0, 8, pa1); PK4(p1, 0, pa2); PK4(p1, 8, pa3);
#undef PK4
}
template <int NR>
__device__ __forceinline__ void qkt(f32x16& p0, f32x16& p1, const char* Ks, const char* Kr, const bf16x8* qr, const char* qrl, int r32, int hi) {
  p0 = f32x16{}; p1 = f32x16{};
#pragma unroll
  for (int d0 = 0; d0 < 8; ++d0) { const int cb = (d0 * 16 + hi * 8) * 2;
    const bf16x8 b0 = *reinterpret_cast<const bf16x8*>(Ks + KSWZ(r32, cb));
    const bf16x8 b1 = *reinterpret_cast<const bf16x8*>(Ks + KSWZ(32 + r32, cb));
    p0 = __builtin_amdgcn_mfma_f32_32x32x16_bf16(b0, qr[d0], p0, 0, 0, 0);
    p1 = __builtin_amdgcn_mfma_f32_32x32x16_bf16(b1, qr[d0], p1, 0, 0, 0); }
#pragma unroll
  for (int d0 = 0; d0 < NR; ++d0) { const int cb = (d0 * 16 + hi * 8) * 2;
    const bf16x8 b0 = *reinterpret_cast<const bf16x8*>(Kr + KRSWZ(r32, cb));
    const bf16x8 b1 = *reinterpret_cast<const bf16x8*>(Kr + KRSWZ(32 + r32, cb));
    const bf16x8 q = *reinterpret_cast<const bf16x8*>(qrl + d0 * 1024);
    p0 = __builtin_amdgcn_mfma_f32_32x32x16_bf16(b0, q, p0, 0, 0, 0);
    p1 = __builtin_amdgcn_mfma_f32_32x32x16_bf16(b1, q, p1, 0, 0, 0); }
}
__device__ __forceinline__ int v_st(int k, int c) { const int kk = (k & ~0xC) | ((k & 4) << 1) | ((k & 8) >> 1); return ((kk >> 3) * 4 + (c >> 5)) * 512 + ((kk & 7) * 32 + (c & 31)) * 2; }
__device__ __forceinline__ int v_rd_base(int lane) { return ((lane & 3) << 3) | (((lane >> 2) & 3) << 6) | (((lane >> 4) & 1) << 5) | (((lane >> 5) & 1) << 8); }
constexpr int v_rd_off(int d0, int ks, int half) { return d0 * 512 + ks * 4096 + half * 2048; }
template <int OFF> __device__ __forceinline__ s16x4 tr_read(int vb) {
  s16x4 r; asm volatile("ds_read_b64_tr_b16 %0, %1 offset:%2" : "=&v"(r) : "v"(vb), "i"(OFF) : "memory"); return r;
}
template <int D0> __device__ __forceinline__ void pv_one(f32x16& od, int vb, bf16x8 pa0, bf16x8 pa1, bf16x8 pa2, bf16x8 pa3) {
  const s16x4 l0 = tr_read<v_rd_off(D0, 0, 0)>(vb), h0 = tr_read<v_rd_off(D0, 0, 1)>(vb), l1 = tr_read<v_rd_off(D0, 1, 0)>(vb), h1 = tr_read<v_rd_off(D0, 1, 1)>(vb);
  const s16x4 l2 = tr_read<v_rd_off(D0, 2, 0)>(vb), h2 = tr_read<v_rd_off(D0, 2, 1)>(vb), l3 = tr_read<v_rd_off(D0, 3, 0)>(vb), h3 = tr_read<v_rd_off(D0, 3, 1)>(vb);
  asm volatile("s_waitcnt lgkmcnt(0)" ::: "memory"); SBAR();
#define PK(L, H) (bf16x8){L[0], L[1], L[2], L[3], H[0], H[1], H[2], H[3]}
  od = __builtin_amdgcn_mfma_f32_32x32x16_bf16(pa0, PK(l0, h0), od, 0, 0, 0);
  od = __builtin_amdgcn_mfma_f32_32x32x16_bf16(pa1, PK(l1, h1), od, 0, 0, 0);
  od = __builtin_amdgcn_mfma_f32_32x32x16_bf16(pa2, PK(l2, h2), od, 0, 0, 0);
  od = __builtin_amdgcn_mfma_f32_32x32x16_bf16(pa3, PK(l3, h3), od, 0, 0, 0);
#undef PK
}
__device__ __forceinline__ void pv_d0(f32x16* o, int vb, bf16x8 pa0, bf16x8 pa1, bf16x8 pa2, bf16x8 pa3) {
  pv_one<0>(o[0], vb, pa0, pa1, pa2, pa3); pv_one<1>(o[1], vb, pa0, pa1, pa2, pa3); pv_one<2>(o[2], vb, pa0, pa1, pa2, pa3); pv_one<3>(o[3], vb, pa0, pa1, pa2, pa3);
}

template <int MODE, int SDEPTH>
__device__ __forceinline__ void attn_unit(const bf16* Qw, const bf16* __restrict__ Kh, const bf16* __restrict__ Vh, const bf16* __restrict__ KRh,
                                          bf16* Ow, int NT_, char* lds, float m0, float l0, int qpos, const int* __restrict__ kposg, int nkeys, const float* __restrict__ btg) {
  constexpr int LD = MODE == 0 ? DM : 256, ldo = DM;
  const int NT = MODE == 0 ? SEQ / KVBLK : NT_;
  constexpr int NQ = 8, NR = MODE == 0 ? 4 : 0;
  int tid_ = threadIdx.x; asm volatile("" : "+v"(tid_));
  const int tid = tid_, wid = tid >> 6, lane = tid & 63, r32 = lane & 31, hi = lane >> 5;
  char* V_lds = lds + L_V; char* K_lds = lds + L_K; char* KR_lds = lds + L_KR;
  float* ws = (float*)(lds + L_WS) + wid * 64; float* li_l = ws; float* al_l = ws + 32;
  const int* kp_l = (const int*)(lds + L_KPOS); const float* bt_l = (const float*)(lds + L_BT) + (wid >> 2) * 260;
  __syncthreads();
  if constexpr (MODE == 1) {
    for (int i = tid; i < nkeys; i += 512) ((int*)(lds + L_KPOS))[i] = kposg[i];
    for (int i = tid; i < 520; i += 512) ((float*)(lds + L_BT))[i] = btg[i];
  }
  float m_reg = m0, l_reg = l0; f32x16 o[4] = {}; bf16x8 qr[NQ];
#pragma unroll
  for (int d0 = 0; d0 < NQ; ++d0) qr[d0] = ld8(Qw + d0 * 16);
  char* const qrl = lds + L_QR + wid * 4096 + hi * 512 + r32 * 16;
  if constexpr (MODE == 0) {
#pragma unroll
    for (int d0 = 0; d0 < 4; ++d0) *(bf16x8*)(qrl + d0 * 1024) = ld8(Qw + NOPE + d0 * 16);
  }
  const int sr = tid >> 4, sc = (tid & 15) * 8, vst0 = v_st(sr, sc), vst1 = v_st(32 + sr, sc);
  const int krr = tid >> 3, krc = (tid & 7) * 8;
  const int vb0 = (int)(uintptr_t)V_lds + v_rd_base(lane);
  struct { bf16x8 vs0, vs1, ks0, ks1, kr; } sr_[SDEPTH];
  const unsigned go0 = (unsigned)(sr * LD + sc), go1 = go0 + 32u * LD, gokr = (unsigned)(krr * ROPE + krc);
#define SLOAD(i, k0) do { const bf16* vt_ = Vh + (size_t)(k0) * LD; const bf16* kt_ = Kh + (size_t)(k0) * LD; \
    sr_[i].vs0 = ld8(vt_ + go0); sr_[i].vs1 = ld8(vt_ + go1); sr_[i].ks0 = ld8(kt_ + go0); sr_[i].ks1 = ld8(kt_ + go1); \
    if constexpr (MODE == 0) { const bf16* rt_ = KRh + (size_t)(k0) * ROPE; sr_[i].kr = ld8(rt_ + gokr); } } while (0)
#define SWRITE(b, i) do { *(bf16x8*)(V_lds + (b) * SHM_V + vst0) = sr_[i].vs0; *(bf16x8*)(V_lds + (b) * SHM_V + vst1) = sr_[i].vs1; const int kc = sc * 2; \
    *(bf16x8*)(K_lds + (b) * SHM_K + KSWZ(sr, kc)) = sr_[i].ks0; *(bf16x8*)(K_lds + (b) * SHM_K + KSWZ(32 + sr, kc)) = sr_[i].ks1; \
    if constexpr (MODE == 0) *(bf16x8*)(KR_lds + (b) * SHM_KR + KRSWZ(krr, krc * 2)) = sr_[i].kr; } while (0)
#define SWAIT() do { if constexpr (SDEPTH == 1) asm volatile("s_waitcnt vmcnt(0)" ::: "memory"); else if constexpr (MODE == 0) asm volatile("s_waitcnt vmcnt(5)" ::: "memory"); else asm volatile("s_waitcnt vmcnt(4)" ::: "memory"); } while (0)
#define RESC(a) do { if (__any((a) < 1.f)) { if (hi == 0) al_l[r32] = (a); asm volatile("s_waitcnt lgkmcnt(0)" ::: "memory"); \
    for (int d = 0; d < 4; ++d) for (int r = 0; r < 16; ++r) o[d][r] *= al_l[crow(r, hi)]; } } while (0)
  f32x16 pA0, pA1, pB0, pB1; float mnA, mnB, alA, alB; bf16x8 pa0, pa1, pa2, pa3;
  constexpr int SE = 0, SO = SDEPTH - 1;
  SLOAD(SE, 0); asm volatile("s_waitcnt vmcnt(0)" ::: "memory"); SWRITE(0, SE); __syncthreads();
  qkt<NR>(pA0, pA1, K_lds, KR_lds, qr, qrl, r32, hi); partialSM<MODE == 1>(pA0, pA1, m_reg, mnA, alA, kp_l, qpos, bt_l, hi);
  SLOAD(SO, KVBLK); if constexpr (SDEPTH == 2) { if (2 < NT) SLOAD(SE, 2 * KVBLK); }
  SWAIT(); SWRITE(1, SO); __syncthreads();
  for (int j = 1; j + 1 < NT; j += 2) {
    SBAR(); qkt<NR>(pB0, pB1, K_lds + SHM_K, KR_lds + SHM_KR, qr, qrl, r32, hi);
    finishSM(pA0, pA1, alA, l_reg, pa0, pa1, pa2, pa3); SBAR();
    SLOAD(SO, (j + SDEPTH) * KVBLK); SBAR();
    pv_d0(o, vb0, pa0, pa1, pa2, pa3); partialSM<MODE == 1>(pB0, pB1, m_reg, mnB, alB, kp_l + j * KVBLK, qpos, bt_l, hi);
    __syncthreads(); SWAIT(); SWRITE(0, SE);
    RESC(alB); __syncthreads();
    SBAR(); qkt<NR>(pA0, pA1, K_lds, KR_lds, qr, qrl, r32, hi);
    finishSM(pB0, pB1, alB, l_reg, pa0, pa1, pa2, pa3); SBAR();
    if (SDEPTH == 1 || j + 3 < NT) SLOAD(SE, (j + 1 + SDEPTH) * KVBLK); SBAR();
    pv_d0(o, vb0 + SHM_V, pa0, pa1, pa2, pa3); partialSM<MODE == 1>(pA0, pA1, m_reg, mnA, alA, kp_l + (j + 1) * KVBLK, qpos, bt_l, hi);
    __syncthreads(); SWAIT(); SWRITE(1, SO);
    RESC(alA); __syncthreads();
  }
  SBAR(); qkt<NR>(pB0, pB1, K_lds + SHM_K, KR_lds + SHM_KR, qr, qrl, r32, hi);
  finishSM(pA0, pA1, alA, l_reg, pa0, pa1, pa2, pa3); SBAR();
  pv_d0(o, vb0, pa0, pa1, pa2, pa3); partialSM<MODE == 1>(pB0, pB1, m_reg, mnB, alB, kp_l + (NT - 1) * KVBLK, qpos, bt_l, hi);
  __syncthreads(); RESC(alB);
  finishSM(pB0, pB1, alB, l_reg, pa0, pa1, pa2, pa3); SBAR();
  pv_d0(o, vb0 + SHM_V, pa0, pa1, pa2, pa3);
  if (hi == 0) li_l[r32] = l_reg; asm volatile("s_waitcnt lgkmcnt(0)" ::: "memory");
  float rli[16];
#pragma unroll
  for (int r = 0; r < 16; ++r) rli[r] = __builtin_amdgcn_rcpf(li_l[crow(r, hi)]);
#pragma unroll
  for (int r = 0; r < 16; ++r) { const int orow = crow(r, hi);
#pragma unroll
    for (int d0 = 0; d0 < 4; ++d0) { const float v = o[d0][r] * rli[r]; const unsigned u = __float_as_uint(v); Ow[(long)orow * ldo + d0 * 32 + r32] = (bf16)((u + 0x7fffu + ((u >> 16) & 1u)) >> 16); } }
#undef SLOAD
#undef SWRITE
#undef SWAIT
#undef RESC
}
#undef SBAR
}

constexpr int NWAVES = 8;
constexpr int N_LAUNCHES = MK_N_LAUNCHES;
constexpr int PER_PHASE = 10;
static_assert(N_LAUNCHES == 1 || N_LAUNCHES == PER_PHASE, "MK_N_LAUNCHES is 1 or 10");

constexpr size_t MiB = 1u << 20;
constexpr size_t WS_CTL = 0, CTL_ZERO_BYTES = 1 * MiB;
constexpr size_t CTL_SSQQ = 64 * 1024, CTL_SSQKV = 192 * 1024, CTL_MOD = 320 * 1024, CTL_SSQ2 = 512 * 1024;
constexpr size_t WS_BT = 1 * MiB, WS_CS = 2 * MiB;
constexpr size_t WS_SMALL = 1 * MiB + 64 * 1024;
constexpr size_t WS_WIN = 10 * MiB, WS_WUQ = 19 * MiB, WS_WUKV = 21 * MiB, WS_WO2 = 22 * MiB, WS_WOUT = 26 * MiB, WS_W1 = 28 * MiB, WS_W2 = 36 * MiB;
constexpr size_t WS_XN = 44 * MiB;
constexpr size_t WS_KN = 44 * MiB;
constexpr size_t WS_QS = 108 * MiB;
constexpr size_t WS_KS = 172 * MiB, WS_VS = 188 * MiB, WS_KR = 204 * MiB;
constexpr size_t WS_GT = 208 * MiB;
constexpr size_t WS_LAT = 272 * MiB;
constexpr size_t WS_OA = 272 * MiB;
constexpr size_t WS_QM = 336 * MiB, WS_VM = 432 * MiB;
constexpr size_t WS_T = 336 * MiB, WS_MG = 400 * MiB;
constexpr size_t WS_X1 = 44 * MiB;
constexpr size_t WS_H2 = 172 * MiB;
constexpr size_t WS_U = 236 * MiB;
constexpr size_t WS_END = 496 * MiB;
constexpr int CW_BAR = 4096;

constexpr int RING_OFF = 0, RING_BYTES = 131072;
constexpr int LDSCTL_OFF = RING_BYTES, MISC_OFF = LDSCTL_OFF + 320;
constexpr int LDS_BYTES = 147456;
static_assert(att::L_END <= RING_BYTES, "attention LDS");

#define GAS __attribute__((address_space(1)))
#define LAS __attribute__((address_space(3)))
typedef unsigned short bf16;
typedef unsigned v4u __attribute__((ext_vector_type(4)));
typedef float f32x4 __attribute__((ext_vector_type(4)));
typedef GAS unsigned gu32;
#define RLX_AGENT __ATOMIC_RELAXED, __HIP_MEMORY_SCOPE_AGENT
#define LDS_WAIT() asm volatile("s_waitcnt lgkmcnt(0)" ::: "memory")
#define VM_WAIT() asm volatile("s_waitcnt vmcnt(0)" ::: "memory")
__device__ __forceinline__ unsigned f2bf(float f) { unsigned u = __builtin_bit_cast(unsigned, f); return (u + 0x7fffu + ((u >> 16) & 1u)) >> 16; }
__device__ __forceinline__ unsigned pk2(float lo, float hi) { return f2bf(lo) | (f2bf(hi) << 16); }

#define XB_TMO      128
#define XB_XCNT(j)  (256  + 64 * (j))
#define XB_XSUB(j)  (1280 + 64 * (j))
#define XB_XGEN(j)  (2304 + 64 * (j))
#define XB_TOP      3328
#define XB_TOPGEN   3392
#define XCD_BAR_WORDS 3456
#define XB_SPIN_CAP (1u << 18)
__device__ __forceinline__ unsigned xb_ld(unsigned* p)              { return __hip_atomic_load(p, __ATOMIC_RELAXED, __HIP_MEMORY_SCOPE_AGENT); }
__device__ __forceinline__ unsigned xb_add(unsigned* p, unsigned v) { return __hip_atomic_fetch_add(p, v, __ATOMIC_RELAXED, __HIP_MEMORY_SCOPE_AGENT); }
__device__ __forceinline__ unsigned xb_xcc_id() { return (unsigned)__builtin_amdgcn_s_getreg((3 << 11) | 20) & 0xFu; }
#define XB_SPIN(cond, bar) do { unsigned _sp = 0; while (cond) { __builtin_amdgcn_s_sleep(1); \
    if ((++_sp & 255u) == 0u) { if (xb_ld(&(bar)[XB_TMO])) break; if (_sp > XB_SPIN_CAP) { atomicAdd(&(bar)[XB_TMO], 1u); break; } } } } while (0)
struct XcdBarrier { unsigned* bar; unsigned x; volatile LAS unsigned* st; };
__device__ __forceinline__ XcdBarrier xcd_barrier_post(unsigned* bar, volatile LAS unsigned* st) {
    XcdBarrier b; b.bar = bar; b.x = xb_xcc_id(); b.st = st;
    if (threadIdx.x == 0) (void)xb_add(&bar[XB_XCNT(b.x)], 1u);
    return b;
}
__device__ __forceinline__ void xcd_barrier_complete(unsigned* bar, unsigned x, unsigned& nloc, unsigned& nx) {
    const unsigned G = gridDim.x * gridDim.y * gridDim.z;
    unsigned sum, cnt, mine, sp = 0u;
    for (;;) {
        sum = 0u; cnt = 0u; mine = 0u;
#pragma unroll
        for (unsigned j = 0; j < 16; ++j) { const unsigned c = xb_ld(&bar[XB_XCNT(j)]); sum += c; cnt += (c > 0u) ? 1u : 0u; mine = (j == x) ? c : mine; }
        if (sum == G) break;
        __builtin_amdgcn_s_sleep(1);
        if ((++sp & 255u) == 0u) { if (xb_ld(&bar[XB_TMO])) break; if (sp > XB_SPIN_CAP) { atomicAdd(&bar[XB_TMO], 1u); break; } }
    }
    nloc = mine > 0u ? mine : 1u; nx = cnt > 0u ? cnt : 1u;
}
__device__ __forceinline__ void xcd_barrier(const XcdBarrier& b) {
    asm volatile("s_waitcnt vmcnt(0)" ::: "memory");
    __syncthreads();
    if (threadIdx.x == 0) {
        unsigned* bar = b.bar;
        __builtin_amdgcn_s_waitcnt(0);
        unsigned nloc = b.st[0], nx = b.st[1];
        if (nloc == 0u) { xcd_barrier_complete(bar, b.x, nloc, nx); b.st[0] = nloc; b.st[1] = nx; }
        const unsigned old = xb_add(&bar[XB_XSUB(b.x)], 1u);
        const unsigned gen = old / nloc;
        if (old + 1u == (gen + 1u) * nloc) {
            __builtin_amdgcn_fence(__ATOMIC_RELEASE, "agent");
            asm volatile("s_waitcnt vmcnt(0)" ::: "memory");
            const unsigned og = xb_add(&bar[XB_TOP], 1u);
            const unsigned tg = og / nx;
            if (og + 1u == (tg + 1u) * nx) xb_add(&bar[XB_TOPGEN], 1u);
            else XB_SPIN(xb_ld(&bar[XB_TOPGEN]) == tg, bar);
            __builtin_amdgcn_fence(__ATOMIC_ACQUIRE, "agent");
            xb_add(&bar[XB_XGEN(b.x)], 1u);
            asm volatile("s_waitcnt vmcnt(0)" ::: "memory");
        } else {
            XB_SPIN(xb_ld(&bar[XB_XGEN(b.x)]) == gen, bar);
            __builtin_amdgcn_fence(__ATOMIC_ACQUIRE, "agent");
            asm volatile("s_waitcnt vmcnt(0)" ::: "memory");
        }
    }
    __syncthreads();
}

__device__ __forceinline__ float wave_sum(float v) {
#pragma unroll
    for (int o = 1; o < 64; o <<= 1) v += __shfl_xor(v, o);
    return v;
}
__device__ __forceinline__ int map_col(int mode, int n) {
    if (mode == 1) { if (n < 640) return n; if (n < 704) { const int i = n - 640; return 640 + (i < 32 ? 2 * i : 2 * (i - 32) + 1); } return n + 64; }
    if (mode == 2) { const int h = n / QKD, j = n % QKD; if (j < NOPE) return n; const int i = j - NOPE; return h * QKD + NOPE + (i < 32 ? 2 * i : 2 * (i - 32) + 1); }
    return n;
}
__device__ __forceinline__ void p0_transpose_item(const float* W, int K, int N, bf16* WT, int row_off, int mode, const float* kscale, LAS float* scr, int item, int lane) {
    const int nblk = N / 32, kb = item / nblk, nb = item % nblk, k0 = 64 * kb, n0 = 32 * nb;
#pragma unroll 8
    for (int i = 0; i < 32; ++i) { const int kk = 2 * i + (lane >> 5); float w = W[(size_t)(k0 + kk) * N + n0 + (lane & 31)]; if (kscale) w *= kscale[k0 + kk]; scr[kk * 33 + (lane & 31)] = w; }
    LDS_WAIT(); asm volatile("" ::: "memory");
    const int c = lane & 7;
#pragma unroll
    for (int j = 0; j < 4; ++j) { const int n = (lane >> 3) + 8 * j; const LAS float* s = scr + (8 * c) * 33 + n;
        v4u o; o.x = pk2(s[0 * 33], s[1 * 33]); o.y = pk2(s[2 * 33], s[3 * 33]); o.z = pk2(s[4 * 33], s[5 * 33]); o.w = pk2(s[6 * 33], s[7 * 33]);
        *(GAS v4u*)(WT + (size_t)(row_off + map_col(mode, n0 + n)) * K + k0 + 8 * c) = o; }
    LDS_WAIT(); asm volatile("" ::: "memory");
}
template <bool TO_BF16>
__device__ __forceinline__ void norm_row(const float* xrow, const float* gain, const float* msc, const float* msh, void* orow, int lane) {
    const GAS f32x4* xr = (const GAS f32x4*)xrow + lane;
    f32x4 v[4]; float s = 0.f;
#pragma unroll
    for (int j = 0; j < 4; ++j) { v[j] = xr[64 * j]; s += (v[j].x * v[j].x + v[j].y * v[j].y) + (v[j].z * v[j].z + v[j].w * v[j].w); }
    const float rstd = 1.f / sqrtf(wave_sum(s) * (1.f / DM) + EPS);
#pragma unroll
    for (int j = 0; j < 4; ++j) {
        f32x4 g = ((const GAS f32x4*)gain)[lane + 64 * j]; f32x4 y = v[j] * rstd * g;
        if (msc) { const f32x4 a = ((const GAS f32x4*)msc)[lane + 64 * j], b = ((const GAS f32x4*)msh)[lane + 64 * j]; y = y * (a + 1.f) + b; }
        if constexpr (TO_BF16) ((GAS unsigned long long*)orow)[lane + 64 * j] = (unsigned long long)pk2(y.x, y.y) | ((unsigned long long)pk2(y.z, y.w) << 32);
        else ((GAS f32x4*)orow)[lane + 64 * j] = y;
    }
}

struct Args { const float* in[20]; float* out; unsigned char* ws; int ph_lo, ph_hi, li, pad; };

__global__ void __launch_bounds__(NWAVES * 64, 2) fwd(Args args) {
    extern __shared__ __attribute__((aligned(16))) unsigned char lds[];
    LAS unsigned char* const L = (LAS unsigned char*)lds;
    volatile LAS unsigned* const MISC = (volatile LAS unsigned*)(L + MISC_OFF);
    const int tid = threadIdx.x, lane = tid & 63, wave = __builtin_amdgcn_readfirstlane(tid >> 6);
    const int G = gridDim.x; const int bx = blockIdx.x; const int vcu = (G % 8 == 0) ? (bx % 8) * (G / 8) + bx / 8 : bx;
    unsigned char* const ws = args.ws;
    gu32* const ctl = (gu32*)(ws + WS_CTL);
    const float* x = args.in[0]; const float* cvec = args.in[1]; const int* positions = (const int*)args.in[2];
    const float* w_ada = args.in[3]; const float* b_ada = args.in[4]; const float* norm_mix = args.in[5]; const float* w_in = args.in[6];
    const float* q_norm = args.in[7]; const float* w_uq = args.in[8]; const float* kv_norm = args.in[9]; const float* w_ukv = args.in[10];
    const float* rel_bias = args.in[11]; const float* sink = args.in[12]; const float* w_o_mla = args.in[13]; const float* w_o_swa = args.in[14];
    const float* w_out = args.in[15]; const float* norm_mlp = args.in[16]; const float* w_ff1 = args.in[17]; const float* w_ff2 = args.in[18]; const float* norm_final = args.in[19];
    float* const out = args.out;
    float* const SSQQ = (float*)(ws + CTL_SSQQ); float* const SSQKV = (float*)(ws + CTL_SSQKV); float* const MOD = (float*)(ws + CTL_MOD); float* const SSQ2 = (float*)(ws + CTL_SSQ2);
    float* const BT = (float*)(ws + WS_BT); float* const CS = (float*)(ws + WS_CS);
    float* const c_nmix = (float*)(ws + WS_SMALL); float* const c_nmlp = c_nmix + DM; float* const c_nfin = c_nmix + 2 * DM; float* const c_sink = c_nmix + 3 * DM; int* const c_pos = (int*)(ws + WS_SMALL + 16384);
    float* const GC2 = (float*)(ws + WS_SMALL + 144 * 1024); float* const C2V = (float*)(ws + WS_SMALL + 192 * 1024);
    bf16* const Win_t = (bf16*)(ws + WS_WIN); bf16* const Wuq_t = (bf16*)(ws + WS_WUQ); bf16* const Wukv_t = (bf16*)(ws + WS_WUKV); bf16* const Wo2_t = (bf16*)(ws + WS_WO2);
    bf16* const Wout_t = (bf16*)(ws + WS_WOUT); bf16* const W1_t = (bf16*)(ws + WS_W1); bf16* const W2_t = (bf16*)(ws + WS_W2);
    bf16* const XN = (bf16*)(ws + WS_XN); bf16* const KN = (bf16*)(ws + WS_KN); bf16* const VM = (bf16*)(ws + WS_VM); bf16* const OA = (bf16*)(ws + WS_OA); bf16* const H2 = (bf16*)(ws + WS_H2);
    bf16* const QS = (bf16*)(ws + WS_QS); bf16* const KS = (bf16*)(ws + WS_KS); bf16* const VS = (bf16*)(ws + WS_VS); bf16* const KR = (bf16*)(ws + WS_KR);
    bf16* const LAT = (bf16*)(ws + WS_LAT); bf16* const QM = (bf16*)(ws + WS_QM);
    bf16* const TB = (bf16*)(ws + WS_T); bf16* const MG = (bf16*)(ws + WS_MG); bf16* const UB = (bf16*)(ws + WS_U);
    unsigned char* const GT = ws + WS_GT; float* const X1 = (float*)(ws + WS_X1);

    for (int u = tid; u < (LDS_BYTES - LDSCTL_OFF) / 4; u += NWAVES * 64) ((LAS unsigned*)(L + LDSCTL_OFF))[u] = 0u;
    __syncthreads();
    XcdBarrier bar; bar.bar = (unsigned*)(ctl + CW_BAR); bar.x = 0; bar.st = nullptr;
    if (N_LAUNCHES == 1) bar = xcd_barrier_post((unsigned*)(ctl + CW_BAR), MISC + 8);
#define GRID_BAR() do { if (N_LAUNCHES == 1) xcd_barrier(bar); } while (0)
    const int lo = args.ph_lo, hi = args.ph_hi;
#define IN(k) (lo <= (k) && (k) < hi)
#define BOTH(k) (IN(k) && IN((k) + 1))
    const int gw = vcu * NWAVES + wave, NGW = G * NWAVES;

    if (IN(0)) {
        LAS float* scr = (LAS float*)(L + RING_OFF + wave * 16384);
        constexpr int I_IN = (DM / 64) * (DIN / 32), I_UQ = (QL / 64) * (MH * QKD / 32), I_UKV = (KVL / 64) * (2048 / 32), I_O = (DM / 64) * (DM / 32), I_1 = (DM / 64) * (DFF / 32), I_2 = (DFF / 64) * (DM / 32);
        constexpr int NITEMS = I_IN + I_UQ + I_UKV + 3 * I_O + I_1 + I_2;
        for (int it = gw; it < NITEMS; it += NGW) {
            int r = it;
            if (r < I_IN) { p0_transpose_item(w_in, DM, DIN, Win_t, 0, 1, nullptr, scr, r, lane); continue; } r -= I_IN;
            if (r < I_UQ) { p0_transpose_item(w_uq, QL, MH * QKD, Wuq_t, 0, 2, q_norm, scr, r, lane); continue; } r -= I_UQ;
            if (r < I_UKV) { p0_transpose_item(w_ukv, KVL, 2048, Wukv_t, 0, 0, kv_norm, scr, r, lane); continue; } r -= I_UKV;
            if (r < I_O) { p0_transpose_item(w_o_mla, DM, DM, Wo2_t, 0, 0, nullptr, scr, r, lane); continue; } r -= I_O;
            if (r < I_O) { p0_transpose_item(w_o_swa, DM, DM, Wo2_t, DM, 0, nullptr, scr, r, lane); continue; } r -= I_O;
            if (r < I_O) { p0_transpose_item(w_out, DM, DM, Wout_t, 0, 0, nullptr, scr, r, lane); continue; } r -= I_O;
            if (r < I_1) { p0_transpose_item(w_ff1, DM, DFF, W1_t, 0, 0, nullptr, scr, r, lane); continue; } r -= I_1;
            p0_transpose_item(w_ff2, DFF, DM, W2_t, 0, 0, nullptr, scr, r, lane);
        }
        for (int i = bx * 512 + tid; i < 64 * DM / 8; i += G * 512) ((GAS v4u*)(Win_t + (size_t)704 * DM))[i] = (v4u){0u, 0u, 0u, 0u};
        for (int it = gw; it < 96 * 16; it += NGW) { const int cg = it % 96, ks = it / 96, n = cg * 64 + lane;
            float ca[8], a[8];
#pragma unroll
            for (int b = 0; b < 8; ++b) { const float cv = cvec[b * DM + ks * 64 + lane]; ca[b] = cv / (1.f + __expf(-cv)); a[b] = 0.f; }
#pragma unroll 8
            for (int kk = 0; kk < 64; ++kk) { const float w = w_ada[(size_t)(ks * 64 + kk) * NMOD + n];
#pragma unroll
                for (int b = 0; b < 8; ++b) a[b] += __uint_as_float(__builtin_amdgcn_readlane(__float_as_uint(ca[b]), kk)) * w; }
            const float bb = ks == 0 ? b_ada[n] : 0.f;
#pragma unroll
            for (int b = 0; b < 8; ++b) (void)__hip_atomic_fetch_add(MOD + b * NMOD + n, a[b] + bb, __ATOMIC_RELAXED, __HIP_MEMORY_SCOPE_AGENT);
        }
        for (int idx = bx * 512 + tid; idx < M * 32; idx += G * 512) { const int row = idx >> 5, i = idx & 31;
            const float inv = powf(10000.0f, -(float)(2 * i) / 64.0f); const float ang = (float)positions[row] * inv;
            const double ad = (double)ang; const double kq = rint(ad * 0.15915494309189535); const float rr = (float)(ad - kq * 6.283185307179586);
            CS[2 * idx] = cosf(rr); CS[2 * idx + 1] = sinf(rr); }
        for (int i = bx * 512 + tid; i < M; i += G * 512) c_pos[i] = positions[i];
        if (bx == 1) { for (int i = tid; i < DM; i += 512) { c_nmix[i] = norm_mix[i]; c_nmlp[i] = norm_mlp[i]; c_nfin[i] = norm_final[i]; } if (tid < SH) c_sink[tid] = sink[tid] * LOG2E; }
        if (bx == 0) for (int idx = tid; idx < SH * 257; idx += 512) { const int h = idx / 257, ri = idx % 257, rel = ri - 128, n = rel < 0 ? -rel : rel;
            int bk = n < 8 ? n : 8 + (31 - __clz(n * n)) - 6; if (n >= 8 && bk > 15) bk = 15; if (rel > 0) bk += 16;
            BT[h * 260 + ri] = rel_bias[bk * SH + h] * LOG2E; }
        if (BOTH(0)) GRID_BAR();
    }
    if (IN(1)) {
        int lane_ = lane; asm volatile("" : "+v"(lane_));
        for (int i = bx * 512 + tid; i < BATCH * DM; i += G * 512) GC2[i] = c_nmlp[i & (DM - 1)] * (1.f + MOD[(size_t)(i >> 10) * NMOD + 4 * DM + (i & (DM - 1))]);
        {
            LAS float* part = (LAS float*)(L + RING_OFF);
            const int c = tid & 15, ks = tid >> 4, n0 = bx * 16;
            if (n0 < DFF) { float a[8];
#pragma unroll
                for (int b = 0; b < 8; ++b) a[b] = 0.f;
                for (int kk = 0; kk < 32; ++kk) { const int k = ks * 32 + kk; const float w = w_ff1[(size_t)k * DFF + n0 + c];
#pragma unroll
                    for (int b = 0; b < 8; ++b) a[b] += MOD[(size_t)b * NMOD + 3 * DM + k] * w; }
#pragma unroll
                for (int b = 0; b < 8; ++b) part[(ks * 8 + b) * 16 + c] = a[b]; }
            __syncthreads();
            if (n0 < DFF && tid < 128) { const int b = tid >> 4; float sum = 0.f;
                for (int k2 = 0; k2 < 32; ++k2) sum += part[(k2 * 8 + b) * 16 + c];
                C2V[(size_t)b * DFF + n0 + c] = sum; }
            __syncthreads();
        }
        for (int m = gw; m < M; m += NGW) { const float* mb = MOD + (size_t)(m / SEQ) * NMOD; norm_row<true>(x + (size_t)m * DM, c_nmix, mb + DM, mb, XN + (size_t)m * DM, lane_); }
        if (BOTH(1)) GRID_BAR();
    }
    if (IN(2)) {
        pg8::Gemm g{XN, Win_t, DM, DM}; pg8::StaticOrder S; S.init(M, DINP, G, bx);
        pg8::EpiProj E{LAT, KR, QS, KS, VS, GT, SSQQ, SSQKV, CS};
        pg8::gemm_phase<pg8::EpiProj, pg8::StaticOrder, true>(L + RING_OFF, g, S, E);
        if (BOTH(2)) GRID_BAR();
    }
    if (IN(3)) {
        { pg8::Gemm g{LAT, Wuq_t, LATP, QL}; pg8::StaticOrder S; S.init(M, MH * QKD, G, bx); pg8::EpiQ E{QM, SSQQ, CS};
          pg8::gemm_phase<pg8::EpiQ, pg8::StaticOrder, true>(L + RING_OFF, g, S, E); }
        { pg8::Gemm g{LAT + QL, Wukv_t, LATP, KVL}; pg8::StaticOrder S; S.init(M, 2048, G, bx); pg8::EpiKV E{KN, VM, SSQKV};
          pg8::gemm_phase<pg8::EpiKV, pg8::StaticOrder, true>(L + RING_OFF, g, S, E); }
        if (BOTH(3)) GRID_BAR();
    }
    if (IN(4)) {
        int lane_ = lane; asm volatile("" : "+v"(lane_));
        const int r32 = lane_ & 31, hi5 = lane_ >> 5;
        const int xg = vcu / 32, li = vcu % 32;
        for (int i = 0; i < 4; ++i) {
            const int b = xg, blk = li, kvh = i >> 1, hp = i & 1, h = kvh * 4 + hp * 2 + (wave >> 2);
            const int klo = blk * 128 - 128 < 0 ? 0 : blk * 128 - 128, khi = blk * 128 + 256 > SEQ ? SEQ : blk * 128 + 256, NT = (khi - klo) / 64;
            const int qrow = b * SEQ + blk * 128 + 32 * (wave & 3);
            const att::bf16* Qw = QS + (size_t)(qrow + r32) * DM + h * SHD + hi5 * 8;
            const att::bf16* Kh = KS + (size_t)(b * SEQ + klo) * 256 + kvh * SHD; const att::bf16* Vh = VS + (size_t)(b * SEQ + klo) * 256 + kvh * SHD;
            att::bf16* Ow = QS + (size_t)qrow * DM + h * SHD;
            att::attn_unit<1, 1>(Qw, Kh, Vh, nullptr, Ow, NT, (char*)lds + RING_OFF, c_sink[h], 1.f, c_pos[qrow + r32], c_pos + b * SEQ + klo, khi - klo, BT + (kvh * 4 + hp * 2) * 260);
        }
        for (int i = 0; i < 4; ++i) {
            const int b = xg, h = (li >> 4) * 4 + i, qb = li & 15;
            const int qrow = b * SEQ + qb * 256 + 32 * wave;
            const att::bf16* Qw = QM + (size_t)(qrow + r32) * (MH * QKD) + h * QKD + hi5 * 8;
            const att::bf16* Kh = KN + (size_t)(b * SEQ) * DM + h * NOPE; const att::bf16* Vh = VM + (size_t)(b * SEQ) * DM + h * VD; const att::bf16* KRh = KR + (size_t)(b * SEQ) * ROPE;
            att::bf16* Ow = OA + (size_t)qrow * DM + h * VD;
            att::attn_unit<0, 1>(Qw, Kh, Vh, KRh, Ow, SEQ / 64, (char*)lds + RING_OFF, -1e30f, 0.f, 0, nullptr, 0, nullptr);
        }
        __syncthreads();
        if (BOTH(4)) GRID_BAR();
    }
    if (IN(5)) {
        pg8::Gemm g{OA, Wo2_t, DM, DM}; pg8::PairOrder S; S.so.init(M, DM, G, bx); S.dpm = (int)(((long)WS_QS - (long)WS_OA) / (long)(256 * DM * 2));
        pg8::EpiMerge E{GT, TB, MG, S.dpm, DM / 256};
        pg8::gemm_phase<pg8::EpiMerge, pg8::PairOrder, true>(L + RING_OFF, g, S, E);
        if (BOTH(5)) GRID_BAR();
    }
    if (IN(6)) {
        pg8::Gemm g{MG, Wout_t, DM, DM}; pg8::StaticOrder S; S.init(M, DM, G, bx);
        pg8::EpiResid E{x, X1, MOD + 2 * DM, H2, GC2, SSQ2};
        pg8::gemm_phase<pg8::EpiResid, pg8::StaticOrder, true>(L + RING_OFF, g, S, E);
        if (BOTH(6)) GRID_BAR();
    }
    if (IN(7)) {
        pg8::Gemm g{H2, W1_t, DM, DM}; pg8::StaticOrder S; S.init(M, DFF, G, bx);
        pg8::EpiRelu2 E{UB, SSQ2, C2V};
        pg8::gemm_phase<pg8::EpiRelu2, pg8::StaticOrder, true>(L + RING_OFF, g, S, E);
        if (BOTH(7)) GRID_BAR();
    }
    if (IN(8)) {
        pg8::Gemm g{UB, W2_t, DFF, DFF}; pg8::StaticOrder S; S.init(M, DM, G, bx);
        pg8::EpiResid E{X1, X1, MOD + 5 * DM, nullptr, nullptr, nullptr};
        pg8::gemm_phase<pg8::EpiResid, pg8::StaticOrder, true>(L + RING_OFF, g, S, E);
        if (BOTH(8)) GRID_BAR();
    }
    if (IN(9)) {
        int lane_ = lane; asm volatile("" : "+v"(lane_));
        for (int m = gw; m < M; m += NGW) norm_row<false>(X1 + (size_t)m * DM, c_nfin, nullptr, nullptr, out + (size_t)m * DM, lane_);
        if (N_LAUNCHES == 1) {
            if (xb_ld((unsigned*)(ctl + CW_BAR) + XB_TMO) != 0u) { VM_WAIT(); __syncthreads(); const float q = __builtin_nanf("");
                for (int m = gw; m < M; m += NGW) { GAS f32x4* o = (GAS f32x4*)(out + (size_t)m * DM) + lane_;
#pragma unroll
                    for (int j = 0; j < 4; ++j) o[64 * j] = (f32x4){q, q, q, q}; } }
        }
    }
#undef IN
#undef BOTH
#undef GRID_BAR
}

extern "C" void kernel_launch(void* const* d_in, const int* in_sizes, int n_in, void* d_out, int out_size, void* d_ws, size_t ws_size, hipStream_t stream) {
    static int grid = 0;
    if (grid == 0) {
        if (n_in != 20 || in_sizes[0] != M * DM || out_size != M * DM || ws_size < WS_END) {
            fprintf(stderr, "kernel_launch: built for 20 inputs, x/out of %d floats, >= %zu bytes of workspace; got n_in %d, in0 %d, out %d, ws %zu; nothing launched\n", M * DM, (size_t)WS_END, n_in, n_in > 0 ? in_sizes[0] : -1, out_size, ws_size);
            grid = -1; return; }
        int dev = 0, cus = 0, per_cu = 0;
        if (hipGetDevice(&dev) != hipSuccess || hipDeviceGetAttribute(&cus, hipDeviceAttributeMultiprocessorCount, dev) != hipSuccess) { fprintf(stderr, "kernel_launch: device query failed\n"); grid = -1; return; }
        if (hipFuncSetAttribute((const void*)fwd, hipFuncAttributeMaxDynamicSharedMemorySize, LDS_BYTES) != hipSuccess) { fprintf(stderr, "kernel_launch: hipFuncSetAttribute failed\n"); grid = -1; return; }
        if (hipOccupancyMaxActiveBlocksPerMultiprocessor(&per_cu, (const void*)fwd, NWAVES * 64, LDS_BYTES) != hipSuccess || per_cu < 1)
            fprintf(stderr, "kernel_launch: note: occupancy query reports %d workgroups per CU\n", per_cu);
        (void)hipGetLastError();
        grid = cus;
        if (grid != 256) fprintf(stderr, "kernel_launch: note: %d CUs (the attention unit deal assumes 256)\n", grid);
    }
    if (grid < 0) return;
    if (hipMemsetAsync((char*)d_ws + WS_CTL, 0, CTL_ZERO_BYTES, stream) != hipSuccess) { fprintf(stderr, "kernel_launch: hipMemsetAsync failed\n"); return; }
    Args a{};
    for (int i = 0; i < 20; ++i) a.in[i] = (const float*)d_in[i];
    a.out = (float*)d_out; a.ws = (unsigned char*)d_ws;
    for (int li = 0; li < N_LAUNCHES; ++li) {
        a.ph_lo = (N_LAUNCHES == PER_PHASE) ? li : 0; a.ph_hi = (N_LAUNCHES == PER_PHASE) ? li + 1 : PER_PHASE; a.li = li;
        hipLaunchKernelGGL(fwd, dim3(grid), dim3(NWAVES * 64), LDS_BYTES, stream, a);
        const hipError_t le = hipPeekAtLastError();
        if (le != hipSuccess) { fprintf(stderr, "kernel_launch: launch %d failed: %s\n", li, hipGetErrorName(le)); break; }
    }
}
```
